# Optimizing an MI355X kernel written in HIP

```python
import math
import jax, jax.numpy as jnp
from jax import lax
import numpy as np

D_MODEL = 1024
BATCH = 4
SEQ = 8192
DEPTH = 1

CTX_LEN = 256
GRID_W = 64
N_HEADS = 8
QK_NOPE = 64
QK_ROPE = 32
QK_DIM = QK_NOPE + QK_ROPE
V_DIM = 64
Q_LORA = 384
KV_LORA = 256
ATTN_WIDTH = N_HEADS * V_DIM
ROPE_THETA = 10000.0
ROPE_AXIS_PAIRS = QK_ROPE // 4
Q_BLOCK = 128
SSM_WIDTH = 512
SSM_GROUP = 16
SSM_GROUPS = SSM_WIDTH // SSM_GROUP
SSM_STATE = 64
FFN_HIDDEN = 2816
CONV_W = 3
N_BRANCH = 2
EPS = 1e-6
IN_SPLITS = (Q_LORA, Q_LORA + KV_LORA, Q_LORA + KV_LORA + QK_ROPE,
             Q_LORA + KV_LORA + QK_ROPE + SSM_WIDTH)
IN_WIDTH = Q_LORA + KV_LORA + QK_ROPE + SSM_WIDTH + N_BRANCH * D_MODEL

kernel_name = "hybrid_mla_s5_convffn_prefix_ctx"


def rmsnorm(x, g):
    xf = x.astype(jnp.float32)
    y = xf * lax.rsqrt(jnp.mean(xf * xf, axis=-1, keepdims=True) + EPS)
    return (y * g.astype(jnp.float32)).astype(x.dtype)


def modulate(h, shift, scale):
    return h * (1.0 + scale) + shift


def axial_rope(rows):
    row = jnp.repeat(jnp.arange(rows), GRID_W)
    col = jnp.tile(jnp.arange(GRID_W), rows)
    freqs = ROPE_THETA ** (-jnp.arange(ROPE_AXIS_PAIRS, dtype=jnp.float32) / ROPE_AXIS_PAIRS)
    ang = jnp.concatenate([row[:, None] * freqs, col[:, None] * freqs], axis=-1)
    return jnp.cos(ang), jnp.sin(ang)


def apply_rope(t, cos, sin):
    nope, rope = t[..., :QK_NOPE], t[..., QK_NOPE:]
    r1, r2 = jnp.split(rope, 2, axis=-1)
    cs = cos[:, None, :].astype(t.dtype)
    sn = sin[:, None, :].astype(t.dtype)
    return jnp.concatenate([nope, r1 * cs - r2 * sn, r1 * sn + r2 * cs], axis=-1)


def mla_q(cq, p, cos, sin):
    b, n = cq.shape[:2]
    q = (rmsnorm(cq, p["q_a_g"]) @ p["w_uq"]).reshape(b, n, N_HEADS, QK_DIM)
    q = rmsnorm(q, p["q_norm_g"])
    return q if cos is None else apply_rope(q, cos, sin)


def mla_kv(ckv, krope, p, cos, sin):
    b, n = ckv.shape[:2]
    kv = (rmsnorm(ckv, p["kv_a_g"]) @ p["w_ukv"]).reshape(b, n, N_HEADS, QK_NOPE + V_DIM)
    k_nope, v = jnp.split(kv, [QK_NOPE], axis=-1)
    k_pe = jnp.broadcast_to(krope[:, :, None, :], (b, n, N_HEADS, QK_ROPE))
    k = rmsnorm(jnp.concatenate([k_nope, k_pe], axis=-1), p["k_norm_g"])
    if cos is not None:
        k = apply_rope(k, cos, sin)
    return k, v


def attend(q, k, v):
    s = jnp.einsum("bqhd,bkhd->bhqk", q, k, preferred_element_type=jnp.float32) * (QK_DIM ** -0.5)
    w = jax.nn.softmax(s, axis=-1).astype(v.dtype)
    return jnp.einsum("bhqk,bkhd->bqhd", w, v)


def latent_attention(q, k_lat, v_lat, k_ctx, v_ctx):
    k = jnp.concatenate([k_lat, k_ctx], axis=1)
    v = jnp.concatenate([v_lat, v_ctx], axis=1)
    b, n = q.shape[:2]
    qb = q.reshape(b, n // Q_BLOCK, Q_BLOCK, N_HEADS, QK_DIM).swapaxes(0, 1)
    o = lax.map(lambda qi: attend(qi, k, v), qb)
    return o.swapaxes(0, 1).reshape(b, n, ATTN_WIDTH)


def _ssm_combine(e_i, e_j):
    a_i, b_i = e_i
    a_j, b_j = e_j
    return a_j * a_i, a_j * b_i + b_j


def s5_states(u, p, init_f, init_b):
    b, n = u.shape[:2]
    ug = u.astype(jnp.float32).reshape(b, n, SSM_GROUPS, SSM_GROUP)
    bmat = lax.complex(p["b_re"].astype(jnp.float32), p["b_im"].astype(jnp.float32))
    out = []
    for sfx, init, reverse in (("f", init_f, False), ("b", init_b, True)):
        lam = lax.complex(p["lam_re_" + sfx].astype(jnp.float32), p["lam_im_" + sfx].astype(jnp.float32))
        dt = jnp.exp(p["log_dt_" + sfx].astype(jnp.float32))[:, None]
        lam_bar = jnp.exp(lam * dt)
        b_bar = ((lam_bar - 1.0) / lam)[..., None] * bmat
        bu = jnp.einsum("gnc,bsgc->bsgn", b_bar, ug)
        if init is not None:
            edge = n - 1 if reverse else 0
            bu = bu.at[:, edge].add(lam_bar * init)
        a = jnp.broadcast_to(lam_bar, bu.shape)
        _, xs = lax.associative_scan(_ssm_combine, (a, bu), reverse=reverse, axis=1)
        out.append(xs)
    return out[0], out[1]


def s5_readout(u, xs_f, xs_b, p):
    b, n = u.shape[:2]
    y = u.astype(jnp.float32) * p["d_skip"].astype(jnp.float32)
    for sfx, xs in (("f", xs_f), ("b", xs_b)):
        cm = lax.complex(p["c_re_" + sfx].astype(jnp.float32), p["c_im_" + sfx].astype(jnp.float32))
        y = y + jnp.einsum("gcn,bsgn->bsgc", cm, xs).real.reshape(b, n, SSM_WIDTH)
    return y.astype(u.dtype)


def ssm_glu(y, w_glu):
    val, gate = jnp.split(jax.nn.gelu(y) @ w_glu, 2, axis=-1)
    return val * jax.nn.sigmoid(gate)


def merge_branches(a, s, gate_logits, w_out):
    ga, gs = jnp.split(gate_logits, N_BRANCH, axis=-1)
    return (jax.nn.sigmoid(ga) * a + jax.nn.sigmoid(gs) * s) @ w_out


def dwconv3(u, w, bias):
    up = jnp.pad(u, ((0, 0), (1, 1), (0, 0)))
    return up[:, :-2] * w[0] + up[:, 1:-1] * w[1] + up[:, 2:] * w[2] + bias


def conv_ffn(h, p):
    u = dwconv3(h @ p["w_up"], p["conv_w"], p["conv_b"])
    val, gate = jnp.split(u, 2, axis=-1)
    return (jax.nn.silu(gate) * val) @ p["w_down"]


def hybrid_layer(x, ctx, c, c_ctx, p, cos, sin, update_ctx):
    mod = jax.nn.silu(c) @ p["w_mod"] + p["b_mod"]
    mod_ctx = jax.nn.silu(c_ctx) @ p["w_mod"] + p["b_mod"]
    sh1, sc1, g1, sh2, sc2, g2 = jnp.split(mod[:, None, :], 6, axis=-1)
    csh1, csc1, cg1, csh2, csc2, cg2 = jnp.split(mod_ctx, 6, axis=-1)

    h = modulate(rmsnorm(x, p["norm1_g"]), sh1, sc1)
    hc = modulate(rmsnorm(ctx, p["norm1_g"]), csh1, csc1)
    cq, ckv, kr, u, gl = jnp.split(h @ p["w_in"], IN_SPLITS, axis=-1)
    ccq, cckv, ckr, cu, cgl = jnp.split(hc @ p["w_in"], IN_SPLITS, axis=-1)

    k_c, v_c = mla_kv(cckv, ckr, p, None, None)
    xs_cf, xs_cb = s5_states(cu, p, None, None)

    q_l = mla_q(cq, p, cos, sin)
    k_l, v_l = mla_kv(ckv, kr, p, cos, sin)
    a_l = latent_attention(q_l, k_l, v_l, k_c, v_c) @ p["w_o_attn"]
    xs_f, xs_b = s5_states(u, p, xs_cf[:, -1], xs_cb[:, 0])
    s_l = ssm_glu(s5_readout(u, xs_f, xs_b, p), p["w_glu"])
    x = x + g1 * merge_branches(a_l, s_l, gl, p["w_out"])

    if update_ctx:
        a_c = attend(mla_q(ccq, p, None, None), k_c, v_c).reshape(ctx.shape[0], ctx.shape[1], ATTN_WIDTH)
        s_c = ssm_glu(s5_readout(cu, xs_cf, xs_cb, p), p["w_glu"])
        ctx = ctx + cg1 * merge_branches(a_c @ p["w_o_attn"], s_c, cgl, p["w_out"])

    x = x + g2 * conv_ffn(modulate(rmsnorm(x, p["norm2_g"]), sh2, sc2), p)
    if update_ctx:
        ctx = ctx + cg2 * conv_ffn(modulate(rmsnorm(ctx, p["norm2_g"]), csh2, csc2), p)
    return x, ctx


def setup_inputs(seed: int = 0) -> dict:
    key = jax.random.key(seed)
    ks = iter(jax.random.split(key, 48))
    L, D, G, N, F = DEPTH, D_MODEL, SSM_GROUPS, SSM_STATE, FFN_HIDDEN

    def nrm(shape, scale):
        return jax.random.normal(next(ks), shape, jnp.float32) * scale

    def gain(n):
        return 1.0 + nrm((L, n), 0.02)

    n_idx = jnp.arange(N, dtype=jnp.float32)
    out = {}
    out["x"] = nrm((BATCH, SEQ, D), 1.0)
    out["c"] = nrm((BATCH, D), 1.0)
    out["ctx"] = nrm((BATCH, CTX_LEN, D), 1.0)
    out["c_ctx"] = nrm((D,), 1.0)
    out["w_mod"] = nrm((L, D, 6 * D), 0.5 * D ** -0.5)
    out["b_mod"] = nrm((L, 6 * D), 0.01)
    out["norm1_g"] = gain(D)
    out["norm2_g"] = gain(D)
    out["w_in"] = nrm((L, D, IN_WIDTH), D ** -0.5)
    out["q_a_g"] = gain(Q_LORA)
    out["w_uq"] = nrm((L, Q_LORA, N_HEADS * QK_DIM), Q_LORA ** -0.5)
    out["kv_a_g"] = gain(KV_LORA)
    out["w_ukv"] = nrm((L, KV_LORA, N_HEADS * (QK_NOPE + V_DIM)), KV_LORA ** -0.5)
    out["q_norm_g"] = gain(QK_DIM)
    out["k_norm_g"] = gain(QK_DIM)
    out["w_o_attn"] = nrm((L, ATTN_WIDTH, D), ATTN_WIDTH ** -0.5)
    for sfx in ("f", "b"):
        out["lam_re_" + sfx] = -0.5 + nrm((L, G, N), 0.01)
        out["lam_im_" + sfx] = math.pi * n_idx + nrm((L, G, N), 0.01)
        out["log_dt_" + sfx] = jax.random.uniform(next(ks), (L, G), jnp.float32,
                                                  math.log(1e-3), math.log(1e-1))
        out["c_re_" + sfx] = nrm((L, G, SSM_GROUP, N), (2.0 * N) ** -0.5)
        out["c_im_" + sfx] = nrm((L, G, SSM_GROUP, N), (2.0 * N) ** -0.5)
    out["b_re"] = nrm((L, G, N, SSM_GROUP), (2.0 * SSM_GROUP) ** -0.5)
    out["b_im"] = nrm((L, G, N, SSM_GROUP), (2.0 * SSM_GROUP) ** -0.5)
    out["d_skip"] = nrm((L, SSM_WIDTH), 1.0)
    out["w_glu"] = nrm((L, SSM_WIDTH, 2 * D), SSM_WIDTH ** -0.5)
    out["w_out"] = nrm((L, D, D), D ** -0.5)
    out["w_up"] = nrm((L, D, 2 * F), D ** -0.5)
    out["conv_w"] = nrm((L, CONV_W, 2 * F), CONV_W ** -0.5)
    out["conv_b"] = nrm((L, 2 * F), 0.01)
    out["w_down"] = nrm((L, F, D), F ** -0.5)
    return out


def reference(x, c, ctx, c_ctx, w_mod, b_mod, norm1_g, norm2_g, w_in, q_a_g, w_uq, kv_a_g, w_ukv,
              q_norm_g, k_norm_g, w_o_attn,
              lam_re_f, lam_im_f, log_dt_f, c_re_f, c_im_f,
              lam_re_b, lam_im_b, log_dt_b, c_re_b, c_im_b,
              b_re, b_im, d_skip, w_glu, w_out, w_up, conv_w, conv_b, w_down):
    rows = x.shape[1] // GRID_W
    cos, sin = axial_rope(rows)
    for l in range(DEPTH):
        p = dict(w_mod=w_mod[l], b_mod=b_mod[l], norm1_g=norm1_g[l], norm2_g=norm2_g[l], w_in=w_in[l],
                 q_a_g=q_a_g[l], w_uq=w_uq[l], kv_a_g=kv_a_g[l], w_ukv=w_ukv[l],
                 q_norm_g=q_norm_g[l], k_norm_g=k_norm_g[l], w_o_attn=w_o_attn[l],
                 lam_re_f=lam_re_f[l], lam_im_f=lam_im_f[l], log_dt_f=log_dt_f[l],
                 c_re_f=c_re_f[l], c_im_f=c_im_f[l],
                 lam_re_b=lam_re_b[l], lam_im_b=lam_im_b[l], log_dt_b=log_dt_b[l],
                 c_re_b=c_re_b[l], c_im_b=c_im_b[l],
                 b_re=b_re[l], b_im=b_im[l], d_skip=d_skip[l], w_glu=w_glu[l], w_out=w_out[l],
                 w_up=w_up[l], conv_w=conv_w[l], conv_b=conv_b[l], w_down=w_down[l])
        x, ctx = hybrid_layer(x, ctx, c, c_ctx, p, cos, sin, update_ctx=(l < DEPTH - 1))
    return x
```

```cpp
#include <hip/hip_runtime.h>
#include <hip/hip_cooperative_groups.h>
#include <cstdio>
#include <cstdint>
#include <cmath>
namespace cg = cooperative_groups;

typedef unsigned short bf16_t;
typedef short bf16x8 __attribute__((ext_vector_type(8)));
typedef float f32x4 __attribute__((ext_vector_type(4)));
typedef unsigned u32x4 __attribute__((ext_vector_type(4)));
typedef unsigned u32x2 __attribute__((ext_vector_type(2)));
__device__ __forceinline__ float bf2f(bf16_t v) { return __uint_as_float(((unsigned)v) << 16); }
__device__ __forceinline__ bf16_t f2bf(float f) { unsigned u = __float_as_uint(f); return (bf16_t)((u + 0x7fffu + ((u >> 16) & 1u)) >> 16); }
__device__ __forceinline__ unsigned pk2(float lo, float hi) { unsigned r; asm volatile("v_cvt_pk_bf16_f32 %0, %1, %2" : "=v"(r) : "v"(lo), "v"(hi)); return r; }
__device__ __forceinline__ float lo16(unsigned w) { return __uint_as_float(w << 16); }
__device__ __forceinline__ float hi16(unsigned w) { return __uint_as_float(w & 0xffff0000u); }
__device__ __forceinline__ float sigmoidf_(float v) { return __builtin_amdgcn_rcpf(1.f + __builtin_amdgcn_exp2f(-1.4426950408889634f * v)); }
__device__ __forceinline__ float gelu_tanh(float v) { const float u = 0.7978845608028654f * (v + 0.044715f * v * v * v); return v * sigmoidf_(2.f * u); }
__device__ __forceinline__ float fq_sum(float v) {
  auto a = __builtin_amdgcn_permlane16_swap(__float_as_uint(v), __float_as_uint(v), false, false); v = __uint_as_float(a[0]) + __uint_as_float(a[1]);
  auto b = __builtin_amdgcn_permlane32_swap(__float_as_uint(v), __float_as_uint(v), false, false); return __uint_as_float(b[0]) + __uint_as_float(b[1]);
}
__device__ __forceinline__ float xor32(float v, bool lower) {
  auto b = __builtin_amdgcn_permlane32_swap(__float_as_uint(v), __float_as_uint(v), false, false); return lower ? __uint_as_float(b[1]) : __uint_as_float(b[0]);
}
__device__ __forceinline__ float wave_sum(float v) {
#pragma unroll
  for (int o = 1; o < 64; o <<= 1) v += __shfl_xor(v, o);
  return v;
}

constexpr int D = 1024, NB = 4, SEQ = 8192, CTX = 256, NTOK = NB * SEQ, NCTX = NB * CTX, MALL = NTOK + NCTX;
constexpr int NH = 8, QKD = 96, VD = 64, QL = 384, KVL = 256, AW = 512;
constexpr int SW = 512, NG = 32, SN = 64, FH = 2816, INW = 3232;
constexpr int SKV = SEQ + CTX;
constexpr int KP = 128;
constexpr int CL = 32;
constexpr int NCHL = SEQ / CL, NCHC = CTX / CL;
constexpr int UA_ROWS = 1280, UA_K = 768;
constexpr float EPS = 1e-6f;
constexpr float QSCALE = 0.10206207261596577f * 1.4426950408889634f;
constexpr int WIN_N = 3328;

constexpr size_t MiB = 1u << 20;
constexpr size_t WS_MOD = 0;
constexpr size_t WS_AL = 256 * 1024;
constexpr size_t WS_RSQ = 384 * 1024, WS_RSK = WS_RSQ + 135168, WS_RSR = WS_RSK + 135168;
constexpr size_t WS_BAR = 832 * 1024;
constexpr size_t WS_LBOUND = 320 * 1024;
constexpr size_t WS_RS2 = 65 * MiB;
constexpr size_t WS_BIAS2 = 65 * MiB + 256 * 1024;
constexpr size_t WS_ROPE = 1 * MiB;
constexpr size_t WS_WIN = 2 * MiB;
constexpr size_t WS_WUQ = 9 * MiB;
constexpr size_t WS_WUKV = 10 * MiB;
constexpr size_t WS_WO = 11 * MiB;
constexpr size_t WS_WGLU = 12 * MiB;
constexpr size_t WS_WOUT = 14 * MiB;
constexpr size_t WS_WUP = 16 * MiB;
constexpr size_t WS_WDN = 27 * MiB;
constexpr size_t WS_WT = 33 * MiB;
constexpr size_t WS_W1 = 57 * MiB;
constexpr size_t WS_H = 66 * MiB;
constexpr size_t WS_MS = 66 * MiB;
constexpr size_t WS_H2 = 66 * MiB;
constexpr size_t WS_Y = 66 * MiB;
constexpr size_t WS_S = 66 * MiB;
constexpr size_t WS_CQ = 132 * MiB;
constexpr size_t WS_CKV = 156 * MiB;
constexpr size_t WS_KR = 173 * MiB;
constexpr size_t WS_GY = 132 * MiB;
constexpr size_t WS_MM = 132 * MiB;
constexpr size_t WS_UA = 176 * MiB;
constexpr size_t WS_O = 196 * MiB;
constexpr size_t WS_GL = 236 * MiB;
constexpr size_t WS_Q = 364 * MiB;
constexpr size_t WS_ACT = 236 * MiB;
constexpr size_t WS_K = 412 * MiB;
constexpr size_t WS_V = 478 * MiB;
constexpr size_t WS_NEED = 511 * MiB;

namespace pg8 {
#define PG8_LAS __attribute__((address_space(3)))
constexpr int BM = 256, BK = 64, HALF = 128, HTB = HALF * BK * 2  , STAGE_BYTES = 8 * HTB, NXCD = 8, WGM = 8;
__host__ __device__ __forceinline__ int lds_byte(int r, int c) { const int st = (r >> 4) * 2 + (c >> 5), rr = r & 15, cc = c & 31, ob = rr * 64 + cc * 2; return st * 1024 + (ob ^ (((ob >> 9) & 1) << 5)); }
__host__ __device__ __forceinline__ void stage_rc(int b, int& R, int& C) { const int st = b / 1024, sb = b % 1024, swz = sb ^ (((sb >> 9) & 1) << 5); R = (st >> 1) * 16 + swz / 64; C = (st & 1) * 32 + (swz % 64) / 2; }
__host__ __device__ __forceinline__ int perm32(int rho) { const int n = rho >> 4, i = rho & 15; return 8 * (i >> 2) + 4 * n + (i & 3); }

struct Unit { int pm, pn; const char* a; const char* b; };
struct Gemm { int K, lda, ldb; };

struct TileOrder {
    int nM, nN, nwg, G, c; const char* A; const char* B; size_t tsA, tsB;
    __device__ void init(const void* A_, int lda, const void* B_, int ldb, int M, int N, int G_, int c_) { nM = M / BM; nN = N / BM; nwg = nM * nN; G = G_; c = c_; A = (const char*)A_; B = (const char*)B_; tsA = (size_t)BM * lda * 2; tsB = (size_t)BM * ldb * 2; }
    __device__ bool next(int i, Unit& u) const {
        const long L = (long)i * G + c; if (L >= nwg) return false;
        int wgid = (int)L; { const int q = nwg / NXCD, r = nwg % NXCD, xcd = wgid % NXCD, off = wgid / NXCD; wgid = (xcd < r ? xcd * (q + 1) : r * (q + 1) + (xcd - r) * q) + off; }
        const int nig = WGM * nN, gid = wgid / nig, fm = gid * WGM, gsz = (nM - fm) < WGM ? (nM - fm) : WGM;
        u.pm = fm + ((wgid % nig) % gsz); u.pn = (wgid % nig) / gsz; u.a = A + (size_t)u.pm * tsA; u.b = B + (size_t)u.pn * tsB; return true;
    }
};
template <class Epi, class Sched, bool ALIGN_EPI = false, bool SP2 = false>
__device__ __forceinline__ void gemm_phase(PG8_LAS unsigned char* lds, const Gemm g, const Sched& S, const Epi& E) {
    int tid_ = threadIdx.x; asm volatile("" : "+v"(tid_));
    const int tid = tid_, wid = __builtin_amdgcn_readfirstlane(tid >> 6), lane = tid & 63, wr = wid >> 2, wc = wid & 3, fr = lane & 15, fq = lane >> 4;
    const int K = g.K, nt = K / BK;
    unsigned voffA[2], voffB[2];
#pragma unroll
    for (int i = 0; i < 2; ++i) { int R, C; stage_rc(tid * 16 + i * 8192, R, C); const int Rb = Epi::PERM ? ((R & ~31) + perm32(R & 31)) : R;
        voffA[i] = (unsigned)(R * g.lda + C) * 2u; voffB[i] = (unsigned)(Rb * g.ldb + C) * 2u; }
    const size_t kstep = (size_t)(BK * 2);
    const size_t hstepA = (size_t)HALF * g.lda * 2, hstepB = (size_t)HALF * g.ldb * 2;
    const unsigned ldsw = (unsigned)wid * 1024u;
    const int aoff = lds_byte(wr * 64 + fr, fq * 8), boff = lds_byte(wc * 32 + fr, fq * 8);
#define PG8_SA(b, h) (((b) * 2 + (h)) * HTB)
#define PG8_SB(b, h) ((4 + (b) * 2 + (h)) * HTB)
#define PG8_STAGE(bufoff, gbase, voff) do { _Pragma("unroll") for (int _i = 0; _i < 2; ++_i) \
        __builtin_amdgcn_global_load_lds((const unsigned*)((const char*)(gbase) + (voff)[_i]), (PG8_LAS unsigned*)(lds + (bufoff) + ldsw + _i * 8192), 16, 0, 0); } while (0)
#define PG8_LDA(dst, b, h) do { _Pragma("unroll") for (int m = 0; m < 4; ++m) _Pragma("unroll") for (int k = 0; k < 2; ++k) dst[m][k] = *(const PG8_LAS bf16x8*)(lds + PG8_SA(b, h) + aoff + m * 2048 + k * 1024); } while (0)
#define PG8_LDB(dst, b, h) do { _Pragma("unroll") for (int n = 0; n < 2; ++n) _Pragma("unroll") for (int k = 0; k < 2; ++k) dst[n][k] = *(const PG8_LAS bf16x8*)(lds + PG8_SB(b, h) + boff + n * 2048 + k * 1024); } while (0)
#define PG8_MMA(ai, bj, At, Bt) do { __builtin_amdgcn_s_setprio(1); _Pragma("unroll") for (int m = 0; m < 4; ++m) _Pragma("unroll") for (int n = 0; n < 2; ++n) _Pragma("unroll") for (int k = 0; k < 2; ++k) \
        acc[ai][bj][m][n] = __builtin_amdgcn_mfma_f32_16x16x32_bf16(Bt[n][k], At[m][k], acc[ai][bj][m][n], 0, 0, 0); __builtin_amdgcn_s_setprio(0); } while (0)
#define PG8_WAIT_V(n) asm volatile("s_waitcnt vmcnt(" #n ")" ::: "memory")
#define PG8_WAIT_L(n) asm volatile("s_waitcnt lgkmcnt(" #n ")" ::: "memory")
#define PG8_BAR __builtin_amdgcn_s_barrier()
#define PG8_SCHED __builtin_amdgcn_sched_barrier(0)
    Unit cur, nxt; int ui = 0;
    if (!S.next(0, cur)) return;
    f32x4 acc[2][2][4][2];
#pragma unroll
    for (int a = 0; a < 2; ++a)
#pragma unroll
        for (int b = 0; b < 2; ++b)
#pragma unroll
            for (int m = 0; m < 4; ++m)
#pragma unroll
                for (int n = 0; n < 2; ++n) acc[a][b][m][n] = (f32x4){0.f, 0.f, 0.f, 0.f};
    bf16x8 At[4][2], B0[2][2], B1[2][2];
    const char* cA = cur.a; const char* cB = cur.b;
    if constexpr (SP2) {
        PG8_STAGE(PG8_SB(0, 0), cB, voffB); PG8_STAGE(PG8_SB(0, 1), cB + hstepB, voffB); PG8_STAGE(PG8_SA(0, 0), cA, voffA); PG8_STAGE(PG8_SA(0, 1), cA + hstepA, voffA);
        if (wr == 1) PG8_BAR;
        PG8_WAIT_V(2); PG8_BAR;
        PG8_STAGE(PG8_SB(1, 0), cB + kstep, voffB); PG8_STAGE(PG8_SA(1, 0), cA + kstep, voffA); PG8_STAGE(PG8_SB(1, 1), cB + hstepB + kstep, voffB);
        PG8_WAIT_V(6); PG8_BAR;
    } else {
        PG8_STAGE(PG8_SB(0, 0), cB, voffB); PG8_STAGE(PG8_SA(0, 0), cA, voffA); PG8_STAGE(PG8_SB(0, 1), cB + hstepB, voffB); PG8_STAGE(PG8_SA(0, 1), cA + hstepA, voffA);
        if (wr == 1) PG8_BAR;
        PG8_WAIT_V(4); PG8_BAR;
        PG8_STAGE(PG8_SB(1, 0), cB + kstep, voffB); PG8_STAGE(PG8_SA(1, 0), cA + kstep, voffA); PG8_STAGE(PG8_SB(1, 1), cB + hstepB + kstep, voffB);
        PG8_WAIT_V(6); PG8_BAR;
    }
    for (;;) {
        const bool has_next = S.next(ui + 1, nxt);
        const char* nA = has_next ? nxt.a : cA; const char* nB = has_next ? nxt.b : cB;
        for (int t = 0; t < nt; t += 2) {
            const bool last = (t == nt - 2);
            const char* a1 = cA + (size_t)(t + 1) * kstep;
            const char* a2 = last ? nA : cA + (size_t)(t + 2) * kstep; const char* b2 = last ? nB : cB + (size_t)(t + 2) * kstep;
            const char* a3 = a2 + kstep; const char* b3 = b2 + kstep;
            if constexpr (SP2) {
            PG8_LDB(B0, 0, 0); PG8_LDB(B1, 0, 1); PG8_SCHED; PG8_LDA(At, 0, 0); PG8_STAGE(PG8_SA(1, 1), a1 + hstepA, voffA);
            PG8_WAIT_V(8); PG8_WAIT_L(0); PG8_BAR; PG8_MMA(0, 0, At, B0); PG8_MMA(0, 1, At, B1); PG8_BAR; PG8_SCHED;
            PG8_LDA(At, 0, 1); PG8_STAGE(PG8_SB(0, 0), b2, voffB); PG8_STAGE(PG8_SB(0, 1), b2 + hstepB, voffB); PG8_STAGE(PG8_SA(0, 0), a2, voffA);
            PG8_WAIT_V(8); PG8_WAIT_L(0); PG8_BAR; PG8_MMA(1, 0, At, B0); PG8_MMA(1, 1, At, B1); PG8_BAR; PG8_SCHED;
            PG8_LDB(B0, 1, 0); PG8_LDB(B1, 1, 1); PG8_SCHED; PG8_LDA(At, 1, 0); PG8_STAGE(PG8_SA(0, 1), a2 + hstepA, voffA);
            PG8_WAIT_V(8); PG8_WAIT_L(0); PG8_BAR; PG8_MMA(0, 0, At, B0); PG8_MMA(0, 1, At, B1); PG8_BAR; PG8_SCHED;
            PG8_LDA(At, 1, 1); PG8_STAGE(PG8_SB(1, 0), b3, voffB); PG8_STAGE(PG8_SB(1, 1), b3 + hstepB, voffB); PG8_STAGE(PG8_SA(1, 0), a3, voffA);
            PG8_WAIT_V(8); PG8_WAIT_L(0); PG8_BAR; PG8_MMA(1, 0, At, B0); PG8_MMA(1, 1, At, B1); PG8_BAR; PG8_SCHED;
            } else {
            PG8_LDB(B0, 0, 0); PG8_SCHED; PG8_LDA(At, 0, 0); PG8_STAGE(PG8_SA(1, 1), a1 + hstepA, voffA);
            PG8_WAIT_L(8); PG8_BAR; PG8_WAIT_L(0); PG8_MMA(0, 0, At, B0); PG8_BAR; PG8_SCHED;
            PG8_LDB(B1, 0, 1); PG8_STAGE(PG8_SB(0, 0), b2, voffB);
            PG8_BAR; PG8_WAIT_L(0); PG8_MMA(0, 1, At, B1); PG8_BAR;
            PG8_LDA(At, 0, 1); PG8_STAGE(PG8_SA(0, 0), a2, voffA);
            PG8_BAR; PG8_WAIT_L(0); PG8_MMA(1, 0, At, B0); PG8_BAR; PG8_SCHED;
            PG8_STAGE(PG8_SB(0, 1), b2 + hstepB, voffB);
            PG8_WAIT_V(6); PG8_BAR; PG8_MMA(1, 1, At, B1); PG8_BAR;
            PG8_LDB(B0, 1, 0); PG8_SCHED; PG8_LDA(At, 1, 0); PG8_STAGE(PG8_SA(0, 1), a2 + hstepA, voffA);
            PG8_WAIT_L(8); PG8_BAR; PG8_WAIT_L(0); PG8_MMA(0, 0, At, B0); PG8_BAR; PG8_SCHED;
            PG8_LDB(B1, 1, 1); PG8_STAGE(PG8_SB(1, 0), b3, voffB);
            PG8_BAR; PG8_WAIT_L(0); PG8_MMA(0, 1, At, B1); PG8_BAR;
            PG8_LDA(At, 1, 1); PG8_STAGE(PG8_SA(1, 0), a3, voffA);
            PG8_BAR; PG8_WAIT_L(0); PG8_MMA(1, 0, At, B0); PG8_BAR; PG8_SCHED;
            PG8_STAGE(PG8_SB(1, 1), b3 + hstepB, voffB);
            PG8_WAIT_V(6); PG8_BAR; PG8_MMA(1, 1, At, B1); PG8_BAR;
            }
        }
        if constexpr (ALIGN_EPI) { if (wr == 0) PG8_BAR; }
        if constexpr (!Epi::AFTER_DRAIN) { E(acc, cur, wr, wc, fr, fq); }
        if (!has_next) break;
#pragma unroll
        for (int a = 0; a < 2; ++a)
#pragma unroll
            for (int b = 0; b < 2; ++b)
#pragma unroll
                for (int m = 0; m < 4; ++m)
#pragma unroll
                    for (int n = 0; n < 2; ++n) acc[a][b][m][n] = (f32x4){0.f, 0.f, 0.f, 0.f};
        cur = nxt; cA = nA; cB = nB; ++ui;
        if constexpr (ALIGN_EPI) { if (wr == 1) PG8_BAR; }
    }
    PG8_WAIT_V(0);
    if constexpr (!ALIGN_EPI) { if (wr == 0) PG8_BAR; }
    PG8_BAR;
    if constexpr (Epi::AFTER_DRAIN) { E.fused(acc, cur, wr, wc, fr, fq, lds, wid, lane); }
#undef PG8_SA
#undef PG8_SB
#undef PG8_STAGE
#undef PG8_LDA
#undef PG8_LDB
#undef PG8_MMA
#undef PG8_WAIT_V
#undef PG8_WAIT_L
#undef PG8_BAR
#undef PG8_SCHED
}
}
using pg8::Unit;

__device__ __forceinline__ u32x4 pack8(const f32x4 a, const f32x4 b) { u32x4 w; w.x = pk2(a[0], a[1]); w.y = pk2(a[2], a[3]); w.z = pk2(b[0], b[1]); w.w = pk2(b[2], b[3]); return w; }
__device__ __forceinline__ void unpack8(const u32x4 w, float (&o)[8]) { o[0] = lo16(w.x); o[1] = hi16(w.x); o[2] = lo16(w.y); o[3] = hi16(w.y); o[4] = lo16(w.z); o[5] = hi16(w.z); o[6] = lo16(w.w); o[7] = hi16(w.w); }

struct EpiIn {
  static constexpr bool PERM = true, AFTER_DRAIN = false;
  bf16_t *CQ, *CKV, *KR, *UA, *GL; float *RSQ, *RSK, *RSR;
  __device__ __forceinline__ void operator()(const f32x4 (&acc)[2][2][4][2], const Unit& u, int wr, int wc, int fr, int fq) const {
#pragma unroll
    for (int ai = 0; ai < 2; ++ai)
#pragma unroll
      for (int m = 0; m < 4; ++m) {
        const int row = u.pm * 256 + ai * 128 + wr * 64 + m * 16 + fr;
#pragma unroll
        for (int bj = 0; bj < 2; ++bj) {
          const int col = u.pn * 256 + bj * 128 + wc * 32 + 8 * fq;
          const u32x4 w = pack8(acc[ai][bj][m][0], acc[ai][bj][m][1]);
          if (col < 672) { const f32x4 a0 = acc[ai][bj][m][0], a1 = acc[ai][bj][m][1];
            float ss = (a0[0] * a0[0] + a0[1] * a0[1]) + (a0[2] * a0[2] + a0[3] * a0[3]) + (a1[0] * a1[0] + a1[1] * a1[1]) + (a1[2] * a1[2] + a1[3] * a1[3]);
            ss = fq_sum(ss);
            if (fq == 0) { if (col < 384) atomicAdd(RSQ + row, ss); else if (col < 640) atomicAdd(RSK + row, ss); else RSR[row] = ss; } }
          if (col < 384) { if (row < NTOK) *(u32x4*)(CQ + (size_t)row * 384 + col) = w; }
          else if (col < 640) *(u32x4*)(CKV + (size_t)row * 256 + (col - 384)) = w;
          else if (col < 672) *(u32x4*)(KR + (size_t)row * 32 + (col - 640)) = w;
          else if (col < 1184) { const int j = col - 672, g = j >> 4, jj = j & 15; int crow, s;
            if (row < NTOK) { const int b = row / SEQ, t = row % SEQ; crow = b * NCHL + t / CL; s = t % CL; }
            else { const int mc = row - NTOK, b = mc / CTX, t = mc % CTX; crow = NB * NCHL + b * NCHC + t / CL; s = t % CL; }
            *(u32x4*)(UA + ((size_t)g * UA_ROWS + crow) * UA_K + s * 16 + jj) = w; }
          else if (col < 1280) { }
          else { if (row < NTOK) *(u32x4*)(GL + (size_t)row * 2048 + (col - 1280)) = w; }
        }
      }
  }
};
struct EpiGlu {
  static constexpr bool PERM = true, AFTER_DRAIN = false;
  const bf16_t* GL; bf16_t* MS;
  __device__ __forceinline__ void operator()(const f32x4 (&acc)[2][2][4][2], const Unit& u, int wr, int wc, int fr, int fq) const {
    const int col = u.pn * 128 + wc * 32 + 8 * fq, row0 = u.pm * 256 + wr * 64 + fr;
    u32x4 buf[2][4];
#define GLU_LOAD(ai, d) do { _Pragma("unroll") for (int m = 0; m < 4; ++m) d[m] = *(const u32x4*)(GL + (size_t)(row0 + (ai) * 128 + m * 16) * 2048 + 1024 + col); } while (0)
#define GLU_DO(ai, d) do { _Pragma("unroll") for (int m = 0; m < 4; ++m) { float gs[8]; unpack8(d[m], gs); f32x4 o0, o1; \
      _Pragma("unroll") for (int e = 0; e < 4; ++e) { o0[e] = sigmoidf_(gs[e]) * acc[ai][0][m][0][e] * sigmoidf_(acc[ai][1][m][0][e]); o1[e] = sigmoidf_(gs[4 + e]) * acc[ai][0][m][1][e] * sigmoidf_(acc[ai][1][m][1][e]); } \
      *(u32x4*)(MS + (size_t)(row0 + (ai) * 128 + m * 16) * 1024 + col) = pack8(o0, o1); } } while (0)
    GLU_LOAD(0, buf[0]); GLU_LOAD(1, buf[1]); GLU_DO(0, buf[0]); GLU_DO(1, buf[1]);
#undef GLU_LOAD
#undef GLU_DO
  }
};
struct EpiWo {
  static constexpr bool PERM = true, AFTER_DRAIN = false;
  const bf16_t* GL; const bf16_t* MS; bf16_t* MM;
  __device__ __forceinline__ void operator()(const f32x4 (&acc)[2][2][4][2], const Unit& u, int wr, int wc, int fr, int fq) const {
    const int col0 = u.pn * 256 + wc * 32 + 8 * fq, row0 = u.pm * 256 + wr * 64 + fr;
    u32x4 bg[2][4], bm[2][4];
#define WO_LOAD(ai, mh, dg, dm) do { _Pragma("unroll") for (int mm = 0; mm < 2; ++mm) _Pragma("unroll") for (int bj = 0; bj < 2; ++bj) { const size_t r = (size_t)(row0 + (ai) * 128 + ((mh) * 2 + mm) * 16); \
      dg[mm * 2 + bj] = *(const u32x4*)(GL + r * 2048 + col0 + bj * 128); dm[mm * 2 + bj] = *(const u32x4*)(MS + r * 1024 + col0 + bj * 128); } } while (0)
#define WO_DO(ai, mh, dg, dm) do { _Pragma("unroll") for (int mm = 0; mm < 2; ++mm) _Pragma("unroll") for (int bj = 0; bj < 2; ++bj) { const int m = (mh) * 2 + mm; float ga[8], ms[8]; unpack8(dg[mm * 2 + bj], ga); unpack8(dm[mm * 2 + bj], ms); f32x4 o0, o1; \
      _Pragma("unroll") for (int e = 0; e < 4; ++e) { o0[e] = sigmoidf_(ga[e]) * acc[ai][bj][m][0][e] + ms[e]; o1[e] = sigmoidf_(ga[4 + e]) * acc[ai][bj][m][1][e] + ms[4 + e]; } \
      *(u32x4*)(MM + (size_t)(row0 + (ai) * 128 + m * 16) * 1024 + col0 + bj * 128) = pack8(o0, o1); } } while (0)
    WO_LOAD(0, 0, bg[0], bm[0]); WO_LOAD(0, 1, bg[1], bm[1]); WO_DO(0, 0, bg[0], bm[0]);
    WO_LOAD(1, 0, bg[0], bm[0]); WO_DO(0, 1, bg[1], bm[1]);
    WO_LOAD(1, 1, bg[1], bm[1]); WO_DO(1, 0, bg[0], bm[0]); WO_DO(1, 1, bg[1], bm[1]);
#undef WO_LOAD
#undef WO_DO
  }
};
struct EpiRes {
  static constexpr bool PERM = true, AFTER_DRAIN = false;
  const float* base; const float* mod; int goff; float* out;
  __device__ __forceinline__ void operator()(const f32x4 (&acc)[2][2][4][2], const Unit& u, int wr, int wc, int fr, int fq) const {
    const int col0 = u.pn * 256 + wc * 32 + 8 * fq, row0 = u.pm * 256 + wr * 64 + fr, b = (u.pm * 256) / SEQ;
    f32x4 g[2][2];
#pragma unroll
    for (int bj = 0; bj < 2; ++bj)
#pragma unroll
      for (int n = 0; n < 2; ++n) g[bj][n] = *(const f32x4*)(mod + b * 6144 + goff + col0 + bj * 128 + 4 * n);
    f32x4 bb[2][8];
#define RES_LOAD(ai, mh, d) do { _Pragma("unroll") for (int mm = 0; mm < 2; ++mm) _Pragma("unroll") for (int bj = 0; bj < 2; ++bj) _Pragma("unroll") for (int n = 0; n < 2; ++n) \
      d[(mm * 2 + bj) * 2 + n] = *(const f32x4*)(base + (size_t)(row0 + (ai) * 128 + ((mh) * 2 + mm) * 16) * 1024 + col0 + bj * 128 + 4 * n); } while (0)
#define RES_DO(ai, mh, d) do { _Pragma("unroll") for (int mm = 0; mm < 2; ++mm) _Pragma("unroll") for (int bj = 0; bj < 2; ++bj) _Pragma("unroll") for (int n = 0; n < 2; ++n) \
      *(f32x4*)(out + (size_t)(row0 + (ai) * 128 + ((mh) * 2 + mm) * 16) * 1024 + col0 + bj * 128 + 4 * n) = d[(mm * 2 + bj) * 2 + n] + g[bj][n] * acc[ai][bj][(mh) * 2 + mm][n]; } while (0)
    RES_LOAD(0, 0, bb[0]); RES_LOAD(0, 1, bb[1]); RES_DO(0, 0, bb[0]);
    RES_LOAD(1, 0, bb[0]); RES_DO(0, 1, bb[1]);
    RES_LOAD(1, 1, bb[1]); RES_DO(1, 0, bb[0]); RES_DO(1, 1, bb[1]);
#undef RES_LOAD
#undef RES_DO
  }
};


struct EpiRes2 {
  static constexpr bool PERM = true, AFTER_DRAIN = false;
  const float* base; const float* mod; const float* n2g; float* out; bf16_t* XB; float* RS2;
  __device__ __forceinline__ void operator()(const f32x4 (&acc)[2][2][4][2], const Unit& u, int wr, int wc, int fr, int fq) const {
    const int col0 = u.pn * 256 + wc * 32 + 8 * fq, row0 = u.pm * 256 + wr * 64 + fr, b = (u.pm * 256) / SEQ;
    f32x4 g[2][2], gg[2][2];
#pragma unroll
    for (int bj = 0; bj < 2; ++bj)
#pragma unroll
      for (int n = 0; n < 2; ++n) { const int c = col0 + bj * 128 + 4 * n; g[bj][n] = *(const f32x4*)(mod + b * 6144 + 2048 + c); gg[bj][n] = *(const f32x4*)(n2g + c) * (*(const f32x4*)(mod + b * 6144 + 4096 + c) + 1.f); }
    f32x4 bb[2][4];
#define RES_LOAD(k, d) do { _Pragma("unroll") for (int bj = 0; bj < 2; ++bj) _Pragma("unroll") for (int n = 0; n < 2; ++n) \
      d[bj * 2 + n] = *(const f32x4*)(base + (size_t)(row0 + ((k) >> 2) * 128 + ((k) & 3) * 16) * 1024 + col0 + bj * 128 + 4 * n); } while (0)
#define RES_DO(k, d) do { const size_t r_ = (size_t)(row0 + ((k) >> 2) * 128 + ((k) & 3) * 16); float ss = 0.f; \
      _Pragma("unroll") for (int bj = 0; bj < 2; ++bj) { const f32x4 v0 = d[bj * 2] + g[bj][0] * acc[(k) >> 2][bj][(k) & 3][0], v1 = d[bj * 2 + 1] + g[bj][1] * acc[(k) >> 2][bj][(k) & 3][1]; \
        *(f32x4*)(out + r_ * 1024 + col0 + bj * 128) = v0; *(f32x4*)(out + r_ * 1024 + col0 + bj * 128 + 4) = v1; \
        ss += (v0[0] * v0[0] + v0[1] * v0[1]) + (v0[2] * v0[2] + v0[3] * v0[3]) + (v1[0] * v1[0] + v1[1] * v1[1]) + (v1[2] * v1[2] + v1[3] * v1[3]); \
        *(u32x4*)(XB + r_ * 1024 + col0 + bj * 128) = pack8(v0 * gg[bj][0], v1 * gg[bj][1]); } \
      ss = fq_sum(ss); if (fq == 0) atomicAdd(RS2 + r_, ss); } while (0)
    RES_LOAD(0, bb[0]);
#pragma unroll
    for (int k = 0; k < 8; ++k) { if (k + 1 < 8) RES_LOAD(k + 1, bb[(k + 1) & 1]); RES_DO(k, bb[k & 1]); }
#undef RES_LOAD
#undef RES_DO
  }
};

template <int CTRL> __device__ __forceinline__ float dppf(float old, float src) {
  return __builtin_bit_cast(float, __builtin_amdgcn_update_dpp(__builtin_bit_cast(int, old), __builtin_bit_cast(int, src), CTRL, 0xf, 0xf, false));
}
struct EpiUp {
  static constexpr bool PERM = true, AFTER_DRAIN = false;
  const float* conv_w; const float* conv_b; bf16_t* ACT; float* ex; const float* RS2; const float* bias2;
  template <bool PREV, bool NEXT>
  static __device__ __forceinline__ void shift4(f32x4& o, const f32x4 a, const f32x4 c, const f32x4 ap, const f32x4 cn, float m0, float m15) {
    float o0 = o[0], o1 = o[1], o2 = o[2], o3 = o[3];
    asm volatile("s_nop 1\n\t"
      "v_add_f32_dpp %0, %4, %0 row_shr:1 row_mask:0xf bank_mask:0xf bound_ctrl:1\n\tv_add_f32_dpp %0, %8, %0 row_shl:1 row_mask:0xf bank_mask:0xf bound_ctrl:1\n\t"
      "v_add_f32_dpp %1, %5, %1 row_shr:1 row_mask:0xf bank_mask:0xf bound_ctrl:1\n\tv_add_f32_dpp %1, %9, %1 row_shl:1 row_mask:0xf bank_mask:0xf bound_ctrl:1\n\t"
      "v_add_f32_dpp %2, %6, %2 row_shr:1 row_mask:0xf bank_mask:0xf bound_ctrl:1\n\tv_add_f32_dpp %2, %10, %2 row_shl:1 row_mask:0xf bank_mask:0xf bound_ctrl:1\n\t"
      "v_add_f32_dpp %3, %7, %3 row_shr:1 row_mask:0xf bank_mask:0xf bound_ctrl:1\n\tv_add_f32_dpp %3, %11, %3 row_shl:1 row_mask:0xf bank_mask:0xf bound_ctrl:1"
      : "+v"(o0), "+v"(o1), "+v"(o2), "+v"(o3) : "v"(a[0]), "v"(a[1]), "v"(a[2]), "v"(a[3]), "v"(c[0]), "v"(c[1]), "v"(c[2]), "v"(c[3]));
    if constexpr (PREV) asm volatile("s_nop 1\n\t"
      "v_fmac_f32_dpp %0, %4, %8 row_ror:1 row_mask:0xf bank_mask:0xf\n\tv_fmac_f32_dpp %1, %5, %8 row_ror:1 row_mask:0xf bank_mask:0xf\n\t"
      "v_fmac_f32_dpp %2, %6, %8 row_ror:1 row_mask:0xf bank_mask:0xf\n\tv_fmac_f32_dpp %3, %7, %8 row_ror:1 row_mask:0xf bank_mask:0xf"
      : "+v"(o0), "+v"(o1), "+v"(o2), "+v"(o3) : "v"(ap[0]), "v"(ap[1]), "v"(ap[2]), "v"(ap[3]), "v"(m0));
    if constexpr (NEXT) asm volatile("s_nop 1\n\t"
      "v_fmac_f32_dpp %0, %4, %8 row_ror:15 row_mask:0xf bank_mask:0xf\n\tv_fmac_f32_dpp %1, %5, %8 row_ror:15 row_mask:0xf bank_mask:0xf\n\t"
      "v_fmac_f32_dpp %2, %6, %8 row_ror:15 row_mask:0xf bank_mask:0xf\n\tv_fmac_f32_dpp %3, %7, %8 row_ror:15 row_mask:0xf bank_mask:0xf"
      : "+v"(o0), "+v"(o1), "+v"(o2), "+v"(o3) : "v"(cn[0]), "v"(cn[1]), "v"(cn[2]), "v"(cn[3]), "v"(m15));
    o = (f32x4){o0, o1, o2, o3};
  }
  __device__ __forceinline__ void operator()(const f32x4 (&acc)[2][2][4][2], const Unit& u, int wr_, int wc_, int fr_, int fq_) const {
    int fr = fr_, fq = fq_, wr = wr_, wc = wc_; asm volatile("" : "+v"(fr), "+v"(fq), "+s"(wr), "+s"(wc));
    const int b = u.pm / 33, ti = u.pm % 33, lc0 = wc * 32 + 8 * fq;
    float* rsL = ex + 2048;
#pragma unroll
    for (int ai = 0; ai < 2; ++ai) { const int seg = 2 * ai + wr;
#pragma unroll
      for (int m = 0; m < 4; ++m) { const int lr_ = ai * 128 + wr * 64 + m * 16 + fr; int t_ = 254 * ti - 1 + lr_; t_ = t_ < 0 ? 0 : (t_ > SEQ - 1 ? SEQ - 1 : t_);
        const float r_ = rsqrtf(RS2[b * SEQ + t_] * (1.f / 1024.f) + EPS); if (wc == 0 && fq == 0) rsL[lr_] = r_;
        if (m == 0 && fr == 0) {
#pragma unroll
          for (int bj = 0; bj < 2; ++bj)
#pragma unroll
            for (int n = 0; n < 2; ++n) *(f32x4*)(ex + ((seg * 2 + 0) * 2 + bj) * 128 + lc0 + 4 * n) = acc[ai][bj][0][n] * r_; }
        if (m == 3 && fr == 15) {
#pragma unroll
          for (int bj = 0; bj < 2; ++bj)
#pragma unroll
            for (int n = 0; n < 2; ++n) *(f32x4*)(ex + ((seg * 2 + 1) * 2 + bj) * 128 + lc0 + 4 * n) = acc[ai][bj][3][n] * r_; } } }
    asm volatile("s_waitcnt lgkmcnt(0)" ::: "memory"); __builtin_amdgcn_s_barrier(); asm volatile("" ::: "memory");
    const float m0 = fr == 0 ? 1.f : 0.f, m15 = fr == 15 ? 1.f : 0.f;
    const bool zp = (ti == 0 && wr == 0 && fr == 0), zn = (ti == 32 && wr == 1 && fr == 1);
#pragma unroll
    for (int n = 0; n < 2; ++n) {
      const int col = u.pn * 128 + lc0 + 4 * n;
      f32x4 w0[2], w1[2], w2[2], bs[2];
#pragma unroll
      for (int bj = 0; bj < 2; ++bj) { w0[bj] = *(const f32x4*)(conv_w + bj * FH + col); w1[bj] = *(const f32x4*)(conv_w + 5632 + bj * FH + col); w2[bj] = *(const f32x4*)(conv_w + 2 * 5632 + bj * FH + col); bs[bj] = *(const f32x4*)(conv_b + bj * FH + col);
        bs[bj] += *(const f32x4*)(bias2 + b * 5632 + u.pn * 256 + bj * 128 + lc0 + 4 * n) * (w0[bj] + w1[bj] + w2[bj]); }
#pragma unroll
      for (int ai = 0; ai < 2; ++ai) { const int seg = 2 * ai + wr;
        f32x4 ap[2], en[2];
#pragma unroll
        for (int bj = 0; bj < 2; ++bj) {
          const f32x4 pe = seg > 0 ? *(const f32x4*)(ex + (((seg - 1) * 2 + 1) * 2 + bj) * 128 + lc0 + 4 * n) : (f32x4){0.f, 0.f, 0.f, 0.f};
          const f32x4 ne = seg < 3 ? *(const f32x4*)(ex + (((seg + 1) * 2 + 0) * 2 + bj) * 128 + lc0 + 4 * n) : (f32x4){0.f, 0.f, 0.f, 0.f};
          ap[bj] = w0[bj] * pe; en[bj] = w2[bj] * ne; }
#pragma unroll
        for (int m = 0; m < 4; ++m) {
          f32x4 vg[2]; const int lrm = ai * 128 + wr * 64 + m * 16 + fr; const float rsm = rsL[lrm], rsn = rsL[lrm + (m < 3 ? 16 : 0)];
#pragma unroll
          for (int bj = 0; bj < 2; ++bj) {
            const f32x4 x = acc[ai][bj][m][n] * rsm;
            f32x4 a = w0[bj] * x, c = w2[bj] * x, o = w1[bj] * x + bs[bj];
            if (ai == 0 && m == 0) { if (zp) a = (f32x4){0.f, 0.f, 0.f, 0.f}; if (zn) c = (f32x4){0.f, 0.f, 0.f, 0.f};
              if ((ti == 0 && wr == 0) || (ti == 32 && wr == 1)) { const f32x4 b2 = *(const f32x4*)(bias2 + b * 5632 + u.pn * 256 + bj * 128 + lc0 + 4 * n);
                if (ti == 0 && wr == 0 && fr == 1) o -= b2 * w0[bj]; if (ti == 32 && wr == 1 && fr == 0) o -= b2 * w2[bj]; } }
            if (m == 0) { o += ap[bj] * m0; const f32x4 cn = w2[bj] * (acc[ai][bj][1][n] * rsn); shift4<false, true>(o, a, c, a, cn, m0, m15); }
            else if (m == 3) { o += en[bj] * m15; shift4<true, false>(o, a, c, ap[bj], c, m0, m15); }
            else { const f32x4 cn = w2[bj] * (acc[ai][bj][m == 3 ? 3 : m + 1][n] * rsn); shift4<true, true>(o, a, c, ap[bj], cn, m0, m15); }
            ap[bj] = a; vg[bj] = o; }
          const int lr = ai * 128 + wr * 64 + m * 16 + fr, t = 254 * ti - 1 + lr;
          { const f32x4 val = vg[0], gate = vg[1];
            u32x2 w; w.x = pk2(gate[0] * sigmoidf_(gate[0]) * val[0], gate[1] * sigmoidf_(gate[1]) * val[1]); w.y = pk2(gate[2] * sigmoidf_(gate[2]) * val[2], gate[3] * sigmoidf_(gate[3]) * val[3]);
            if (lr >= 1 && lr <= 254 && t < SEQ) *(u32x2*)(ACT + ((size_t)(b * SEQ + t)) * FH + col) = w; } }
      }
    }
  }
};
struct UpOrder {
  pg8::TileOrder T; const char* A;
  __device__ bool next(int i, Unit& u) const {
    if (!T.next(i, u)) return false;
    const int b = u.pm / 33, ti = u.pm % 33; u.a = A + ((long)(b * SEQ + 254 * ti - 1)) * 2048; return true;
  }
};


struct EpiS {
  static constexpr bool PERM = true, AFTER_DRAIN = false;
  float* S;
  __device__ __forceinline__ void operator()(const f32x4 (&acc)[2][2][4][2], const Unit& u, int wr, int wc, int fr, int fq) const {
#pragma unroll
    for (int ai = 0; ai < 2; ++ai)
#pragma unroll
      for (int m = 0; m < 4; ++m) { const int row = u.pm * 256 + ai * 128 + wr * 64 + m * 16 + fr; float* o = S + ((size_t)u.pn * UA_ROWS + row) * 256 + wc * 32 + 8 * fq;
#pragma unroll
        for (int bj = 0; bj < 2; ++bj)
#pragma unroll
          for (int n = 0; n < 2; ++n) *(f32x4*)(o + bj * 128 + 4 * n) = acc[ai][bj][m][n]; }
  }
};
struct EpiY {
  static constexpr bool PERM = true, AFTER_DRAIN = false;
  bf16_t* GY;
  __device__ __forceinline__ void operator()(const f32x4 (&acc)[2][2][4][2], const Unit& u, int wr, int wc, int fr, int fq) const {
    const int g = u.pn >> 1, pn = u.pn & 1;
#pragma unroll
    for (int ai = 0; ai < 2; ++ai)
#pragma unroll
      for (int m = 0; m < 4; ++m) { const int row = u.pm * 256 + ai * 128 + wr * 64 + m * 16 + fr, b = row >> 8, c = row & 255;
#pragma unroll
        for (int bj = 0; bj < 2; ++bj) { const int col = pn * 256 + bj * 128 + wc * 32 + 8 * fq, i = col >> 4, p0 = col & 15;
          f32x4 o0, o1;
#pragma unroll
          for (int e = 0; e < 4; ++e) { o0[e] = gelu_tanh(acc[ai][bj][m][0][e]); o1[e] = gelu_tanh(acc[ai][bj][m][1][e]); }
          *(u32x4*)(GY + ((size_t)(b * SEQ + c * CL + i)) * SW + g * 16 + p0) = pack8(o0, o1); } }
  }
};
struct CtxOrder {
  int G, c; const char* A; const char* B;
  __device__ bool next(int i, Unit& u) const { const int first = (G >= NG * 5 + 16) ? NG * 5 : 0; const int L = i * G + c - first; if (L < 0 || L >= 16) return false;
    u.pm = NTOK / 256 + L / 4; u.pn = L % 4; u.a = A + (size_t)u.pm * 256 * KVL * 2; u.b = B + (size_t)u.pn * 256 * KVL * 2; return true; }
};
struct SOrder {
  int G, c; const char* A; const char* B;
  __device__ bool next(int i, Unit& u) const { const int L = i * G + c; if (L >= NG * 5) return false; const int g = L / 5; u.pm = L % 5; u.pn = g;
    u.a = A + ((size_t)g * UA_ROWS + u.pm * 256) * UA_K * 2; u.b = B + (size_t)g * 256 * 512 * 2; return true; }
};
struct YOrder {
  int G, c; const char* A; const char* B;
  __device__ bool next(int i, Unit& u) const { const int L = i * G + c; if (L >= NG * 8) return false; const int g = L >> 3; u.pm = (L & 7) >> 1; u.pn = g * 2 + (L & 1);
    u.a = A + ((size_t)g * UA_ROWS + u.pm * 256) * UA_K * 2; u.b = B + ((size_t)g * 512 + (L & 1) * 256) * UA_K * 2; return true; }
};


struct EpiQ {
  static constexpr bool PERM = true, AFTER_DRAIN = false;
  const float* RSQ; const float* qng; const float* rope; bf16_t* Q; float* ex;
  __device__ __forceinline__ void operator()(const f32x4 (&acc)[2][2][4][2], const Unit& u, int wr_, int wc_, int fr_, int fq_) const {
    int fr = fr_, fq = fq_, wr = wr_, wc = wc_; asm volatile("" : "+v"(fr), "+v"(fq), "+s"(wr), "+s"(wc));
    float rsqv[2][4];
#pragma unroll
    for (int ai = 0; ai < 2; ++ai)
#pragma unroll
      for (int m = 0; m < 4; ++m) rsqv[ai][m] = RSQ[u.pm * 256 + ai * 128 + wr * 64 + m * 16 + fr];
#pragma unroll
    for (int ai = 0; ai < 2; ++ai)
#pragma unroll
      for (int m = 0; m < 4; ++m) { const int lr = ai * 128 + wr * 64 + m * 16 + fr;
#pragma unroll
        for (int bj = 0; bj < 2; ++bj) { const int bc = bj * 4 + wc; const f32x4 a0 = acc[ai][bj][m][0], a1 = acc[ai][bj][m][1];
          float ss = (a0[0] * a0[0] + a0[1] * a0[1]) + (a0[2] * a0[2] + a0[3] * a0[3]) + (a1[0] * a1[0] + a1[1] * a1[1]) + (a1[2] * a1[2] + a1[3] * a1[3]);
          ss = fq_sum(ss);
          if (fq == 0) ex[lr * 8 + bc] = ss; }
        asm volatile("" ::: "memory"); }
    asm volatile("s_waitcnt lgkmcnt(0)" ::: "memory"); __builtin_amdgcn_s_barrier(); asm volatile("" ::: "memory");
    const bool needr = (wc == 1 || wc == 2);
    f32x4 gq[2][2];
#pragma unroll
    for (int bj = 0; bj < 2; ++bj)
#pragma unroll
      for (int n = 0; n < 2; ++n) { const int bc = bj * 4 + wc; gq[bj][n] = bc < 6 ? *(const f32x4*)(qng + (bc % 3) * 32 + 8 * fq + 4 * n) : (f32x4){0.f, 0.f, 0.f, 0.f}; }
    f32x4 rp[2][4];
#define Q_RLOAD(k, d) do { const int t_ = (u.pm * 256 + ((k) >> 2) * 128 + wr * 64 + ((k) & 3) * 16 + fr) % SEQ; const float* rb_ = rope + (t_ * 16 + 8 * (fq & 1)) * 2; \
      d[0] = *(const f32x4*)(rb_); d[1] = *(const f32x4*)(rb_ + 4); d[2] = *(const f32x4*)(rb_ + 8); d[3] = *(const f32x4*)(rb_ + 12); } while (0)
    if (needr) Q_RLOAD(0, rp[0]);
#pragma unroll
    for (int k = 0; k < 8; ++k) { const int ai = k >> 2, m = k & 3;
      if (needr && k + 1 < 8) Q_RLOAD(k + 1, rp[(k + 1) & 1]);
      const int lr = ai * 128 + wr * 64 + m * 16 + fr, row = u.pm * 256 + lr, b = row / SEQ, t = row % SEQ;
      const float rsq = rsqrtf(rsqv[ai][m] * (1.f / QL) + EPS);
#pragma unroll
      for (int bj = 0; bj < 2; ++bj) { const int bc = bj * 4 + wc;
        if (bc < 6) { const int hh = bc / 3, third = bc % 3, h = u.pn * 2 + hh;
          const float tot = rsq * rsq * (ex[lr * 8 + 3 * hh] + ex[lr * 8 + 3 * hh + 1] + ex[lr * 8 + 3 * hh + 2]);
          const float sc = rsq * rsqrtf(tot * (1.f / QKD) + EPS) * QSCALE;
#pragma unroll
          for (int n = 0; n < 2; ++n) { const int d0 = third * 32 + 8 * fq + 4 * n; float v[4];
#pragma unroll
            for (int e = 0; e < 4; ++e) v[e] = acc[ai][bj][m][n][e] * sc * gq[bj][n][e];
            if (third == 2) { const f32x4 r0 = rp[k & 1][2 * n], r1 = rp[k & 1][2 * n + 1];
              const float cs[4] = {r0[0], r0[2], r1[0], r1[2]}, sn[4] = {r0[1], r0[3], r1[1], r1[3]};
#pragma unroll
              for (int e = 0; e < 4; ++e) { const float other = xor32(v[e], fq < 2);
                v[e] = fq < 2 ? v[e] * cs[e] - other * sn[e] : other * sn[e] + v[e] * cs[e]; } }
            u32x2 w; w.x = pk2(v[0], v[1]); w.y = pk2(v[2], v[3]);
            *(u32x2*)(Q + ((size_t)(b * NH + h) * SEQ + t) * QKD + d0) = w; } } } }
#undef Q_RLOAD
  }
};
struct EpiKV {
  static constexpr bool PERM = true, AFTER_DRAIN = false;
  const float* RSK; const float* RSR; const bf16_t* KR; const float* kng; const float* rope; bf16_t* Kb; bf16_t* Vb; float* ex;
  __device__ __forceinline__ void operator()(const f32x4 (&acc)[2][2][4][2], const Unit& u, int wr_, int wc_, int fr_, int fq_) const {
    int fr = fr_, fq = fq_, wr = wr_, wc = wc_; asm volatile("" : "+v"(fr), "+v"(fq), "+s"(wr), "+s"(wc));
    float rskv[2][4], rsrv[2][4];
#pragma unroll
    for (int ai = 0; ai < 2; ++ai)
#pragma unroll
      for (int m = 0; m < 4; ++m) { const int row = u.pm * 256 + ai * 128 + wr * 64 + m * 16 + fr; rskv[ai][m] = RSK[row]; rsrv[ai][m] = RSR[row]; }
    if (wc < 2) {
#pragma unroll
      for (int ai = 0; ai < 2; ++ai)
#pragma unroll
        for (int m = 0; m < 4; ++m) { const int lr = ai * 128 + wr * 64 + m * 16 + fr;
#pragma unroll
          for (int bj = 0; bj < 2; ++bj) { const f32x4 a0 = acc[ai][bj][m][0], a1 = acc[ai][bj][m][1];
            float ss = (a0[0] * a0[0] + a0[1] * a0[1]) + (a0[2] * a0[2] + a0[3] * a0[3]) + (a1[0] * a1[0] + a1[1] * a1[1]) + (a1[2] * a1[2] + a1[3] * a1[3]);
            ss = fq_sum(ss);
            if (fq == 0) ex[lr * 4 + bj * 2 + wc] = ss; }
          asm volatile("" ::: "memory"); }
    }
    asm volatile("s_waitcnt lgkmcnt(0)" ::: "memory"); __builtin_amdgcn_s_barrier(); asm volatile("" ::: "memory");
    const bool latent = u.pm * 256 < NTOK, kr_wave = (wc == 2);
    const f32x4 g0 = *(const f32x4*)(kng + (wc & 1) * 32 + 8 * fq), g1 = *(const f32x4*)(kng + (wc & 1) * 32 + 8 * fq + 4);
    const f32x4 gk0 = *(const f32x4*)(kng + 64 + 8 * fq), gk1 = *(const f32x4*)(kng + 64 + 8 * fq + 4);
    f32x4 rp[4]; u32x2 kw[2];
#define KV_RLOAD(k) do { const int row_ = u.pm * 256 + ((k) >> 2) * 128 + wr * 64 + ((k) & 3) * 16 + fr; kw[0] = *(const u32x2*)(KR + (size_t)row_ * 32 + 8 * fq); kw[1] = *(const u32x2*)(KR + (size_t)row_ * 32 + 8 * fq + 4); \
      if (latent) { const float* rb_ = rope + ((row_ % SEQ) * 16 + 8 * (fq & 1)) * 2; rp[0] = *(const f32x4*)(rb_); rp[1] = *(const f32x4*)(rb_ + 4); rp[2] = *(const f32x4*)(rb_ + 8); rp[3] = *(const f32x4*)(rb_ + 12); } } while (0)
    if (kr_wave) KV_RLOAD(0);
#pragma unroll
    for (int k = 0; k < 8; ++k) { const int ai = k >> 2, m = k & 3;
      float base[2][4];
      if (kr_wave) {
#pragma unroll
        for (int n = 0; n < 2; ++n) { const u32x2 w_ = kw[n]; float v[4] = {lo16(w_.x), hi16(w_.x), lo16(w_.y), hi16(w_.y)}; const f32x4 gk = n ? gk1 : gk0;
#pragma unroll
          for (int e = 0; e < 4; ++e) v[e] *= gk[e];
          if (latent) { const f32x4 r0 = rp[2 * n], r1 = rp[2 * n + 1];
            const float cs[4] = {r0[0], r0[2], r1[0], r1[2]}, sn[4] = {r0[1], r0[3], r1[1], r1[3]};
#pragma unroll
            for (int e = 0; e < 4; ++e) { const float other = xor32(v[e], fq < 2);
              v[e] = fq < 2 ? v[e] * cs[e] - other * sn[e] : other * sn[e] + v[e] * cs[e]; } }
#pragma unroll
          for (int e = 0; e < 4; ++e) base[n][e] = v[e]; }
        if (k + 1 < 8) KV_RLOAD(k + 1);
      }
      const int lr = ai * 128 + wr * 64 + m * 16 + fr, row = u.pm * 256 + lr;
      int b, key;
      if (latent) { b = row / SEQ; key = row % SEQ; } else { const int mc = row - NTOK; b = mc / CTX; key = SEQ + mc % CTX; }
      const float rsk = rsqrtf(rskv[ai][m] * (1.f / KVL) + EPS), rsr = rsrv[ai][m];
#pragma unroll
      for (int bj = 0; bj < 2; ++bj) { const int h = u.pn * 2 + bj; const size_t kvrow = (size_t)(b * NH + h) * SKV + key;
        const float r2 = rsqrtf((rsk * rsk * (ex[lr * 4 + bj * 2] + ex[lr * 4 + bj * 2 + 1]) + rsr) * (1.f / QKD) + EPS);
        if (wc < 2) { const int d0 = wc * 32 + 8 * fq; f32x4 o0, o1;
#pragma unroll
          for (int e = 0; e < 4; ++e) { o0[e] = acc[ai][bj][m][0][e] * rsk * r2 * g0[e]; o1[e] = acc[ai][bj][m][1][e] * rsk * r2 * g1[e]; }
          *(u32x4*)(Kb + kvrow * KP + d0) = pack8(o0, o1); }
        else { const int d0 = (wc - 2) * 32 + 8 * fq;
          *(u32x4*)(Vb + kvrow * VD + d0) = pack8(acc[ai][bj][m][0] * rsk, acc[ai][bj][m][1] * rsk);
          if (kr_wave) { u32x4 w; w.x = pk2(base[0][0] * r2, base[0][1] * r2); w.y = pk2(base[0][2] * r2, base[0][3] * r2); w.z = pk2(base[1][0] * r2, base[1][1] * r2); w.w = pk2(base[1][2] * r2, base[1][3] * r2);
            *(u32x4*)(Kb + kvrow * KP + 64 + 8 * fq) = w; } } } }
#undef KV_RLOAD
  }
};

struct InOrder {
  pg8::TileOrder T; int G, c; const char* A; const char* B;
  __device__ bool next(int i, Unit& u) const {
    if (T.next(i, u)) return true;
    const long L = (long)i * G + c - T.nwg; if (L < 0 || L >= 16) return false;
    u.pm = 128 + (int)L / 4; u.pn = 1 + (int)L % 4; u.a = A + (size_t)u.pm * T.tsA; u.b = B + (size_t)u.pn * T.tsB; return true;
  }
};

namespace att {
using f32x16 = __attribute__((ext_vector_type(16))) float;
using s16x4 = __attribute__((ext_vector_type(4))) short;
constexpr int QBLK = 32, KVBLK = 64, NW = 8;
constexpr float SCALE = 0.10206207261596577f;
constexpr float THR = 8.f;
constexpr int SHM_V = KVBLK * 64 * 2, SHM_K = KVBLK * 128 * 2, SHM_ATTN = 2 * SHM_V + 2 * SHM_K + NW * 64 * 4;
#define KSWZ(row, colB) ((row) * 256 + ((colB) ^ (((row) & 7) << 4)))
#define SBAR() __builtin_amdgcn_sched_barrier(0)
__device__ __forceinline__ int crow(int r, int hi) { return (r & 3) + 8 * (r >> 2) + 4 * hi; }
template <bool FAST>
__device__ __forceinline__ void partialSM(f32x16& p0, f32x16& p1, float& m_reg, float& mn, float& alpha) {
  if constexpr (!FAST) {
    constexpr float THR2 = THR * 1.4426950408889634f;
    float pmax = p0[0];
#pragma unroll
    for (int r = 1; r < 16; ++r) pmax = fmaxf(pmax, p0[r]);
#pragma unroll
    for (int r = 0; r < 16; ++r) pmax = fmaxf(pmax, p1[r]);
    { auto rr = __builtin_amdgcn_permlane32_swap(__float_as_uint(pmax), __float_as_uint(pmax), false, false);
      pmax = fmaxf(__uint_as_float(rr[0]), __uint_as_float(rr[1])); }
    if (__builtin_expect(__all(pmax - m_reg <= THR2), 1)) { mn = m_reg; alpha = 1.f; }
    else { mn = fmaxf(m_reg, pmax); alpha = __builtin_amdgcn_exp2f(m_reg - mn); m_reg = mn; }
#pragma unroll
    for (int r = 0; r < 16; ++r) p0[r] -= mn;
#pragma unroll
    for (int r = 0; r < 16; ++r) p1[r] -= mn;
  } else { alpha = 1.f; }
#pragma unroll
  for (int r = 0; r < 16; ++r) p0[r] = __builtin_amdgcn_exp2f(p0[r]);
}
__device__ __forceinline__ void finishSM(f32x16& p0, f32x16& p1, float alpha, float& l_reg, bf16x8& pa0, bf16x8& pa1, bf16x8& pa2, bf16x8& pa3) {
#pragma unroll
  for (int r = 0; r < 16; ++r) p1[r] = __builtin_amdgcn_exp2f(p1[r]);
  float ps = 0;
#pragma unroll
  for (int r = 0; r < 16; ++r) ps += p0[r];
#pragma unroll
  for (int r = 0; r < 16; ++r) ps += p1[r];
  { auto rr = __builtin_amdgcn_permlane32_swap(__float_as_uint(ps), __float_as_uint(ps), false, false);
    ps = __uint_as_float(rr[0]) + __uint_as_float(rr[1]); }
  l_reg = l_reg * alpha + ps;
#define PK4(P, BASE, OUT) do { unsigned a0 = pk2(P[BASE + 0], P[BASE + 1]), a1 = pk2(P[BASE + 2], P[BASE + 3]);   \
    unsigned b0 = pk2(P[BASE + 4], P[BASE + 5]), b1 = pk2(P[BASE + 6], P[BASE + 7]);                              \
    auto r0 = __builtin_amdgcn_permlane32_swap(a0, b0, false, false); auto r1 = __builtin_amdgcn_permlane32_swap(a1, b1, false, false); \
    u32x4 w = {r0[0], r1[0], r0[1], r1[1]}; OUT = *reinterpret_cast<bf16x8*>(&w); } while (0)
  PK4(p0, 0, pa0); PK4(p0, 8, pa1); PK4(p1, 0, pa2); PK4(p1, 8, pa3);
#undef PK4
}
__device__ __forceinline__ void qkt(f32x16& p0, f32x16& p1, const char* Ks, const bf16x8* qr, int r32, int hi) {
  p0 = f32x16{}; p1 = f32x16{};
#pragma unroll
  for (int d0 = 0; d0 < 6; ++d0) { const int cb = (d0 * 16 + hi * 8) * 2;
    const bf16x8 b0 = *reinterpret_cast<const bf16x8*>(Ks + KSWZ(r32, cb));
    const bf16x8 b1 = *reinterpret_cast<const bf16x8*>(Ks + KSWZ(32 + r32, cb));
    p0 = __builtin_amdgcn_mfma_f32_32x32x16_bf16(b0, qr[d0], p0, 0, 0, 0);
    p1 = __builtin_amdgcn_mfma_f32_32x32x16_bf16(b1, qr[d0], p1, 0, 0, 0); }
}
__device__ __forceinline__ int v_st(int k, int c) { const int kk = (k & ~0xC) | ((k & 4) << 1) | ((k & 8) >> 1); return ((kk >> 3) * 2 + (c >> 5)) * 512 + ((kk & 7) * 32 + (c & 31)) * 2; }
__device__ __forceinline__ int v_rd_base(int lane) { return ((lane & 3) << 3) | (((lane >> 2) & 3) << 6) | (((lane >> 4) & 1) << 5) | (((lane >> 5) & 1) << 8); }
constexpr int v_rd_off(int d0, int ks, int half) { return d0 * 512 + ks * 2048 + half * 1024; }
template <int OFF> __device__ __forceinline__ s16x4 tr_read(int vb) {
  s16x4 r; asm volatile("ds_read_b64_tr_b16 %0, %1 offset:%2" : "=&v"(r) : "v"(vb), "i"(OFF) : "memory"); return r;
}
template <int D0> __device__ __forceinline__ void pv_one(f32x16& od, int vb, bf16x8 pa0, bf16x8 pa1, bf16x8 pa2, bf16x8 pa3) {
  const s16x4 l0 = tr_read<v_rd_off(D0, 0, 0)>(vb), h0 = tr_read<v_rd_off(D0, 0, 1)>(vb), l1 = tr_read<v_rd_off(D0, 1, 0)>(vb), h1 = tr_read<v_rd_off(D0, 1, 1)>(vb);
  const s16x4 l2 = tr_read<v_rd_off(D0, 2, 0)>(vb), h2 = tr_read<v_rd_off(D0, 2, 1)>(vb), l3 = tr_read<v_rd_off(D0, 3, 0)>(vb), h3 = tr_read<v_rd_off(D0, 3, 1)>(vb);
  asm volatile("s_waitcnt lgkmcnt(0)" ::: "memory"); SBAR();
#define PK(L, H) (bf16x8){L[0], L[1], L[2], L[3], H[0], H[1], H[2], H[3]}
  od = __builtin_amdgcn_mfma_f32_32x32x16_bf16(pa0, PK(l0, h0), od, 0, 0, 0);
  od = __builtin_amdgcn_mfma_f32_32x32x16_bf16(pa1, PK(l1, h1), od, 0, 0, 0);
  od = __builtin_amdgcn_mfma_f32_32x32x16_bf16(pa2, PK(l2, h2), od, 0, 0, 0);
  od = __builtin_amdgcn_mfma_f32_32x32x16_bf16(pa3, PK(l3, h3), od, 0, 0, 0);
#undef PK
}
__device__ __forceinline__ void pv_d0(f32x16* o, int vb, bf16x8 pa0, bf16x8 pa1, bf16x8 pa2, bf16x8 pa3) {
  pv_one<0>(o[0], vb, pa0, pa1, pa2, pa3); pv_one<1>(o[1], vb, pa0, pa1, pa2, pa3);
}
template <bool FAST>
__device__ __forceinline__ void attn_unit(const bf16_t* __restrict__ Qb, const bf16_t* __restrict__ Kh, const bf16_t* __restrict__ Vh, bf16_t* __restrict__ Ob, int seq, char* lds) {
  const int tid = threadIdx.x, wid = tid >> 6, lane = tid & 63, r32 = lane & 31, hi = lane >> 5;
  char* V_lds = lds; char* K_lds = lds + 2 * SHM_V;
  float* wsf = (float*)(lds + 2 * SHM_V + 2 * SHM_K) + wid * 64; float* li_l = wsf; float* al_l = wsf + 32;
  float m_reg = FAST ? 0.f : -1e30f, l_reg = 0; f32x16 o[2] = {}; bf16x8 qr[6];
  const bf16_t* Qw = Qb + (long)(wid * QBLK + r32) * QKD + hi * 8;
#pragma unroll
  for (int d0 = 0; d0 < 6; ++d0) qr[d0] = *reinterpret_cast<const bf16x8*>(Qw + d0 * 16);
  const int sr = tid >> 4, sc = (tid & 15) * 8;
  const int vk = tid >> 3, vc = (tid & 7) * 8, vst = v_st(vk, vc);
  const int vb0 = (int)(uintptr_t)V_lds + v_rd_base(lane);
  struct { bf16x8 vs, ks0, ks1; } sr_[2];
#define SLOAD(i, k0) do { sr_[i].vs = *reinterpret_cast<const bf16x8*>(&Vh[(long)((k0) + vk) * VD + vc]); \
    sr_[i].ks0 = *reinterpret_cast<const bf16x8*>(&Kh[(long)((k0) + sr) * KP + sc]); sr_[i].ks1 = *reinterpret_cast<const bf16x8*>(&Kh[(long)((k0) + 32 + sr) * KP + sc]); } while (0)
#define SWRITE(b, i) do { *(bf16x8*)(V_lds + (b) * SHM_V + vst) = sr_[i].vs; const int kc = sc * 2;               \
    *(bf16x8*)(K_lds + (b) * SHM_K + KSWZ(sr, kc)) = sr_[i].ks0;                       \
    *(bf16x8*)(K_lds + (b) * SHM_K + KSWZ(32 + sr, kc)) = sr_[i].ks1; } while (0)
#define SWAIT() asm volatile("s_waitcnt vmcnt(3)" ::: "memory")
#define RESC(a) do { if (!FAST && __any((a) < 1.f)) { if (hi == 0) al_l[r32] = (a); asm volatile("s_waitcnt lgkmcnt(0)" ::: "memory"); \
    _Pragma("unroll") for (int d = 0; d < 2; ++d) _Pragma("unroll") for (int r = 0; r < 16; ++r) o[d][r] *= al_l[crow(r, hi)]; } } while (0)
  f32x16 pA0, pA1, pB0, pB1; float mnA, mnB, alA, alB; bf16x8 pa0, pa1, pa2, pa3; const int NT = seq / KVBLK;
  constexpr int SE = 0, SO = 1;
  SLOAD(SE, 0); asm volatile("s_waitcnt vmcnt(0)" ::: "memory"); SWRITE(0, SE); __syncthreads();
  qkt(pA0, pA1, K_lds, qr, r32, hi); partialSM<FAST>(pA0, pA1, m_reg, mnA, alA);
  SLOAD(SO, KVBLK); if (2 < NT) SLOAD(SE, 2 * KVBLK);
  SWAIT(); SWRITE(1, SO); __syncthreads();
  for (int j = 1; j + 1 < NT; j += 2) {
    SBAR(); qkt(pB0, pB1, K_lds + SHM_K, qr, r32, hi);
    finishSM(pA0, pA1, alA, l_reg, pa0, pa1, pa2, pa3); SBAR();
    SLOAD(SO, (j + 2) * KVBLK); SBAR();
    pv_d0(o, vb0, pa0, pa1, pa2, pa3); partialSM<FAST>(pB0, pB1, m_reg, mnB, alB);
    __syncthreads(); SWAIT(); SWRITE(0, SE);
    RESC(alB); __syncthreads();
    SBAR(); qkt(pA0, pA1, K_lds, qr, r32, hi);
    finishSM(pB0, pB1, alB, l_reg, pa0, pa1, pa2, pa3); SBAR();
    if (j + 3 < NT) SLOAD(SE, (j + 3) * KVBLK); SBAR();
    pv_d0(o, vb0 + SHM_V, pa0, pa1, pa2, pa3); partialSM<FAST>(pA0, pA1, m_reg, mnA, alA);
    __syncthreads(); SWAIT(); SWRITE(1, SO);
    RESC(alA); __syncthreads();
  }
  SBAR(); qkt(pB0, pB1, K_lds + SHM_K, qr, r32, hi);
  finishSM(pA0, pA1, alA, l_reg, pa0, pa1, pa2, pa3); SBAR();
  pv_d0(o, vb0, pa0, pa1, pa2, pa3); partialSM<FAST>(pB0, pB1, m_reg, mnB, alB);
  __syncthreads(); RESC(alB);
  finishSM(pB0, pB1, alB, l_reg, pa0, pa1, pa2, pa3); SBAR();
  pv_d0(o, vb0 + SHM_V, pa0, pa1, pa2, pa3);
  if (hi == 0) li_l[r32] = l_reg; asm volatile("s_waitcnt lgkmcnt(0)" ::: "memory");
  bf16_t* Ow = Ob + (long)(wid * QBLK) * AW;
  {
    bf16_t* stg = (bf16_t*)(lds + 53248) + wid * 2048;
#pragma unroll
    for (int r = 0; r < 16; ++r) { const int orow = crow(r, hi); const float rl = __builtin_amdgcn_rcpf(li_l[orow]);
#pragma unroll
      for (int d0 = 0; d0 < 2; ++d0) stg[orow * 64 + d0 * 32 + r32] = f2bf(o[d0][r] * rl); }
    asm volatile("s_waitcnt lgkmcnt(0)" ::: "memory");
#pragma unroll 1
    for (int i = 0; i < 4; ++i) { const int row = i * 8 + (lane >> 3), ch = lane & 7; const u32x4 v = *(const u32x4*)(stg + row * 64 + ch * 8); *(u32x4*)(Ow + (long)row * AW + ch * 8) = v; } }
  __syncthreads();
#undef SLOAD
#undef SWRITE
#undef SWAIT
#undef RESC
}
#undef KSWZ
#undef SBAR
}

struct Params { const float* in[35]; float* out; char* ws; int ph_lo, ph_hi; };
enum { I_X = 0, I_C, I_CTX, I_CCTX, I_WMOD, I_BMOD, I_N1G, I_N2G, I_WIN, I_QAG, I_WUQ, I_KVAG, I_WUKV, I_QNG, I_KNG, I_WOA,
       I_LRF, I_LIF, I_LDTF, I_CRF, I_CIF, I_LRB, I_LIB, I_LDTB, I_CRB, I_CIB, I_BRE, I_BIM, I_DSKIP, I_WGLU, I_WOUT, I_WUP, I_CONVW, I_CONVB, I_WDN };
constexpr int LDS_BYTES = 147456;

__device__ __forceinline__ void tr_item(const float* W, int ldw, int k0, int n0, bf16_t* WT, int ldt, int drow0, const float* kscale, float* scr, int lane) {
#pragma unroll 8
  for (int i = 0; i < 32; ++i) { const int kk = 2 * i + (lane >> 5); float v = W[(size_t)(k0 + kk) * ldw + n0 + (lane & 31)]; if (kscale) v *= kscale[k0 + kk]; scr[kk * 33 + (lane & 31)] = v; }
  asm volatile("s_waitcnt lgkmcnt(0)" ::: "memory");
  const int c = lane & 7;
#pragma unroll
  for (int j = 0; j < 4; ++j) { const int n = (lane >> 3) + 8 * j; const float* s = scr + (8 * c) * 33 + n;
    u32x4 o; o.x = pk2(s[0 * 33], s[1 * 33]); o.y = pk2(s[2 * 33], s[3 * 33]); o.z = pk2(s[4 * 33], s[5 * 33]); o.w = pk2(s[6 * 33], s[7 * 33]);
    *(u32x4*)(WT + (size_t)(drow0 + n) * ldt + k0 + 8 * c) = o; }
  asm volatile("s_waitcnt lgkmcnt(0)" ::: "memory");
}
__device__ __forceinline__ int glu_row(int n0, int half) { return n0 < half ? (n0 / 128) * 256 + (n0 % 128) : ((n0 - half) / 128) * 256 + 128 + ((n0 - half) % 128); }


__device__ __forceinline__ void ssm_tables(const Params& p, unsigned char* lds, int g, int half) {
  const int tid = threadIdx.x;
  constexpr int PWP = 36;
  float* PWr = (float*)lds; float* PWi = PWr + 2 * 64 * PWP; float* CCr = PWi + 2 * 64 * PWP; float* CCi = CCr + 2 * 16 * 64;
  float* BBr = CCi + 2 * 16 * 64; float* BBi = BBr + 2 * 64 * 16; float* TK = BBi + 2 * 64 * 16;
  for (int idx = tid; idx < 2 * 33 * 64; idx += 512) { const int dir = idx / (33 * 64), k = (idx / 64) % 33, n = idx % 64;
    const float lr = p.in[dir ? I_LRB : I_LRF][g * SN + n], li = p.in[dir ? I_LIB : I_LIF][g * SN + n], dt = expf(p.in[dir ? I_LDTB : I_LDTF][g]);
    const float er = expf((float)k * lr * dt); const float sn = sinf((float)k * li * dt), cs = cosf((float)k * li * dt); PWr[(dir * 64 + n) * PWP + k] = er * cs; PWi[(dir * 64 + n) * PWP + k] = er * sn; }
  for (int idx = tid; idx < 2 * 16 * 64; idx += 512) { const int dir = idx / (16 * 64), pn = idx % (16 * 64);
    CCr[idx] = p.in[dir ? I_CRB : I_CRF][g * 16 * 64 + pn]; CCi[idx] = p.in[dir ? I_CIB : I_CIF][g * 16 * 64 + pn]; }
  for (int idx = tid; idx < 2 * 64 * 16; idx += 512) { const int dir = idx / (64 * 16), n = (idx / 16) % 64, j = idx % 16;
    const float lr = p.in[dir ? I_LRB : I_LRF][g * SN + n], li = p.in[dir ? I_LIB : I_LIF][g * SN + n], dt = expf(p.in[dir ? I_LDTB : I_LDTF][g]);
    const float er = expf(lr * dt); const float sn = sinf(li * dt), cs = cosf(li * dt); const float ar = er * cs, ai = er * sn;
    const float den = lr * lr + li * li, nr = ar - 1.f, ni = ai; const float cr = (nr * lr + ni * li) / den, ci = (ni * lr - nr * li) / den;
    const float br = p.in[I_BRE][(g * SN + n) * 16 + j], bi = p.in[I_BIM][(g * SN + n) * 16 + j]; BBr[idx] = cr * br - ci * bi; BBi[idx] = cr * bi + ci * br; }
  __syncthreads();
  { const int dir = tid >> 8, pp = (tid >> 4) & 15, j = tid & 15;
    const float* cr = CCr + (dir * 16 + pp) * 64; const float* ci = CCi + (dir * 16 + pp) * 64; const float* br = BBr + dir * 1024 + j; const float* bi = BBi + dir * 1024 + j;
    f32x4 tk[8];
#pragma unroll
    for (int k = 0; k < 8; ++k) tk[k] = (f32x4){0.f, 0.f, 0.f, 0.f};
    for (int n = 0; n < 64; ++n) { const float zr = cr[n] * br[n * 16] - ci[n] * bi[n * 16], zi = cr[n] * bi[n * 16] + ci[n] * br[n * 16];
      const f32x4* pr = (const f32x4*)(PWr + (dir * 64 + n) * PWP); const f32x4* pi = (const f32x4*)(PWi + (dir * 64 + n) * PWP);
#pragma unroll
      for (int k = 0; k < 8; ++k) tk[k] += pr[k] * zr - pi[k] * zi; }
#pragma unroll
    for (int k = 0; k < 32; ++k) TK[(dir * 32 + k) * 256 + pp * 16 + j] = tk[k >> 2][k & 3]; }
  __syncthreads();
  { bf16_t* WT = (bf16_t*)(p.ws + WS_WT) + (size_t)g * 512 * UA_K; const float* d_skip = p.in[I_DSKIP];
    for (int idx = tid; idx < 256 * (UA_K / 8); idx += 512) { const int r = idx / (UA_K / 8), k0 = (idx % (UA_K / 8)) * 8, i = 16 * half + r / 16, pp = r % 16; float v[8];
      if (k0 < 512) { const int s_ = k0 >> 4, j0 = k0 & 15;
#pragma unroll
        for (int e = 0; e < 8; ++e) v[e] = 0.f;
        if (s_ <= i) { const f32x4 a = *(const f32x4*)(TK + ((i - s_) * 16 + pp) * 16 + j0), b = *(const f32x4*)(TK + ((i - s_) * 16 + pp) * 16 + j0 + 4);
#pragma unroll
          for (int e = 0; e < 4; ++e) { v[e] += a[e]; v[4 + e] += b[e]; } }
        if (s_ >= i) { const f32x4 a = *(const f32x4*)(TK + 8192 + ((s_ - i) * 16 + pp) * 16 + j0), b = *(const f32x4*)(TK + 8192 + ((s_ - i) * 16 + pp) * 16 + j0 + 4);
#pragma unroll
          for (int e = 0; e < 4; ++e) { v[e] += a[e]; v[4 + e] += b[e]; } }
        if (s_ == i && pp >= j0 && pp < j0 + 8) { const float dsk = d_skip[g * 16 + pp];
#pragma unroll
          for (int e = 0; e < 8; ++e) if (j0 + e == pp) v[e] += dsk; } }
      else { const int q = k0 - 512, dir = q >> 7, im = (q >> 6) & 1, n0 = q & 63, pw = dir ? (CL - i) : (i + 1);
#pragma unroll
        for (int e = 0; e < 8; ++e) { const int n = n0 + e; const float cr = CCr[(dir * 16 + pp) * 64 + n], ci = CCi[(dir * 16 + pp) * 64 + n], pr = PWr[(dir * 64 + n) * PWP + pw], pi = PWi[(dir * 64 + n) * PWP + pw];
          v[e] = im ? -(cr * pi + ci * pr) : (cr * pr - ci * pi); } }
      u32x4 w; w.x = pk2(v[0], v[1]); w.y = pk2(v[2], v[3]); w.z = pk2(v[4], v[5]); w.w = pk2(v[6], v[7]);
      *(u32x4*)(WT + (size_t)(i * 16 + pp) * UA_K + k0) = w; } }
  { bf16_t* W1 = (bf16_t*)(p.ws + WS_W1) + (size_t)g * 256 * 512;
    for (int idx = tid; idx < 128 * 64; idx += 512) { const int r = 128 * half + idx / 64, k0 = (idx % 64) * 8, s_ = k0 >> 4, j0 = k0 & 15, dir = r >> 7, im = (r >> 6) & 1, n = r & 63, pw = dir ? s_ : (CL - 1 - s_);
      const float pr = PWr[(dir * 64 + n) * PWP + pw], pi = PWi[(dir * 64 + n) * PWP + pw]; float v[8];
#pragma unroll
      for (int e = 0; e < 8; ++e) { const float br = BBr[dir * 1024 + n * 16 + j0 + e], bi = BBi[dir * 1024 + n * 16 + j0 + e]; v[e] = im ? (pr * bi + pi * br) : (pr * br - pi * bi); }
      u32x4 w; w.x = pk2(v[0], v[1]); w.y = pk2(v[2], v[3]); w.z = pk2(v[4], v[5]); w.w = pk2(v[6], v[7]);
      *(u32x4*)(W1 + (size_t)r * 512 + k0) = w; } }
  if (half == 0 && tid < 128) { const int dir = tid >> 6, n = tid & 63; float* AL = (float*)(p.ws + WS_AL); AL[((g * 2 + dir) * 64 + n) * 2] = PWr[(dir * 64 + n) * PWP + CL]; AL[((g * 2 + dir) * 64 + n) * 2 + 1] = PWi[(dir * 64 + n) * PWP + CL]; }
  __syncthreads();
}

__device__ __forceinline__ void phase_pro(const Params& p, unsigned char* lds) {
  const int tid = threadIdx.x, lane = tid & 63, wave = tid >> 6, G = gridDim.x, blk = blockIdx.x;
  char* ws = p.ws;
  { float* red = (float*)lds; float* sil = (float*)(lds + 16384);
    const float* c = p.in[I_C]; const float* cc = p.in[I_CCTX]; const float* w_mod = p.in[I_WMOD]; const float* b_mod = p.in[I_BMOD]; float* mod = (float*)(ws + WS_MOD);
    if (blk < 192) { for (int i = tid; i < 5 * 1024; i += 512) { const int r = i >> 10, k = i & 1023; const float v = r < 4 ? c[r * 1024 + k] : cc[k]; sil[k * 5 + r] = v * sigmoidf_(v); } __syncthreads(); }
    for (int it = blk; it < 192; it += G) {
      const int col = it * 32 + (tid & 31), kg = tid >> 5; float a[5] = {0.f, 0.f, 0.f, 0.f, 0.f};
#pragma unroll 4
      for (int k = kg * 64; k < kg * 64 + 64; ++k) { const float w = w_mod[(size_t)k * 6144 + col];
#pragma unroll
        for (int r = 0; r < 5; ++r) a[r] += sil[k * 5 + r] * w; }
#pragma unroll
      for (int r = 0; r < 5; ++r) red[(kg * 5 + r) * 32 + (tid & 31)] = a[r];
      __syncthreads();
      if (tid < 160) { const int r = tid >> 5, q = tid & 31; float s = 0.f; for (int g = 0; g < 16; ++g) s += red[(g * 5 + r) * 32 + q]; mod[r * 6144 + it * 32 + q] = s + b_mod[it * 32 + q]; }
      __syncthreads();
    } }
  for (int task = G - 1 - blk; task < 64; task += G) ssm_tables(p, lds, task >> 1, task & 1);
  if (blk == 0 && tid == 0) { float mq = 0.f, mk = 0.f; for (int d = 0; d < QKD; ++d) { mq = fmaxf(mq, fabsf(p.in[I_QNG][d])); mk = fmaxf(mk, fabsf(p.in[I_KNG][d])); } *(float*)(ws + WS_LBOUND) = QSCALE * (float)QKD * mq * mk; }
  { float* tab = (float*)(ws + WS_ROPE);
    for (int idx = blk * 512 + tid; idx < SEQ * 16; idx += G * 512) { const int t = idx >> 4, i = idx & 15; const float freq = powf(10000.f, -(float)(i & 7) / 8.f);
      const float ang = (float)(i < 8 ? (t >> 6) : (t & 63)) * freq; tab[idx * 2] = cosf(ang); tab[idx * 2 + 1] = sinf(ang); } }
  { float* z = (float*)(ws + WS_RSQ); for (int i = blk * 512 + tid; i < 2 * 33792; i += G * 512) z[i] = 0.f; }
  { float* z = (float*)(ws + WS_RS2); for (int i = blk * 512 + tid; i < NTOK; i += G * 512) z[i] = 0.f; }
  { u32x4* z = (u32x4*)((bf16_t*)(ws + WS_WIN) + (size_t)1184 * 1024); for (int i = blk * 512 + tid; i < 96 * 1024 / 8; i += G * 512) z[i] = (u32x4){0u, 0u, 0u, 0u}; }
  if (G < 128 || blk < G - 64)
  { float* scr = (float*)(lds + 16384 + wave * 8704); const int nb_ = G < 128 ? G : G - 64; const int gw = blk * 8 + wave, NGW = nb_ * 8;
    constexpr int I1 = 16 * 101, I2 = 6 * 24, I3 = 4 * 32, I4 = 8 * 32, I5 = 8 * 64, I6 = 16 * 32, I7 = 16 * 176, I8 = 44 * 32;
    for (int it = gw; it < I1 + I2 + I3 + I4 + I5 + I6 + I7 + I8; it += NGW) {
      int r = it;
      if (r < I1) { const int kb = r / 101, nb = r % 101, n0 = nb * 32; tr_item(p.in[I_WIN], INW, kb * 64, n0, (bf16_t*)(ws + WS_WIN), 1024, n0 < 1184 ? n0 : n0 + 96, nullptr, scr, lane); continue; } r -= I1;
      if (r < I2) { const int kb = r / 24, nb = r % 24; const int n0 = nb * 32, hd = n0 / 96; tr_item(p.in[I_WUQ], 768, kb * 64, n0, (bf16_t*)(ws + WS_WUQ), 384, (hd >> 1) * 256 + (hd & 1) * 96 + n0 % 96, p.in[I_QAG], scr, lane); continue; } r -= I2;
      if (r < I3) { const int kb = r / 32, nb = r % 32; tr_item(p.in[I_WUKV], 1024, kb * 64, nb * 32, (bf16_t*)(ws + WS_WUKV), 256, nb * 32, p.in[I_KVAG], scr, lane); continue; } r -= I3;
      if (r < I4) { const int kb = r / 32, nb = r % 32; tr_item(p.in[I_WOA], 1024, kb * 64, nb * 32, (bf16_t*)(ws + WS_WO), 512, nb * 32, nullptr, scr, lane); continue; } r -= I4;
      if (r < I5) { const int kb = r / 64, nb = r % 64; tr_item(p.in[I_WGLU], 2048, kb * 64, nb * 32, (bf16_t*)(ws + WS_WGLU), 512, glu_row(nb * 32, 1024), nullptr, scr, lane); continue; } r -= I5;
      if (r < I6) { const int kb = r / 32, nb = r % 32; tr_item(p.in[I_WOUT], 1024, kb * 64, nb * 32, (bf16_t*)(ws + WS_WOUT), 1024, nb * 32, nullptr, scr, lane); continue; } r -= I6;
      if (r < I7) { const int kb = r / 176, nb = r % 176; tr_item(p.in[I_WUP], 5632, kb * 64, nb * 32, (bf16_t*)(ws + WS_WUP), 1024, glu_row(nb * 32, FH), nullptr, scr, lane); continue; } r -= I7;
      { const int kb = r / 32, nb = r % 32; tr_item(p.in[I_WDN], 1024, kb * 64, nb * 32, (bf16_t*)(ws + WS_WDN), FH, nb * 32, nullptr, scr, lane); }
    } }
}

__device__ __forceinline__ void phase_norm(const float* xin, const float* ctxin, const float* g, const float* mod, int shoff, int scoff, bf16_t* H, int nrows) {
  const int lane = threadIdx.x & 63, gw = blockIdx.x * 8 + (threadIdx.x >> 6), NGW = gridDim.x * 8;
  auto rowsrc = [&](int row, bool ok, const float*& src, int& mr) { if (!ok) { src = xin; mr = 0; } else if (row < NTOK) { src = xin + (size_t)row * 1024; mr = row / SEQ; } else { src = ctxin + (size_t)(row - NTOK) * 1024; mr = 4; } };
  f32x4 v0[4], v1[4]; int mr0 = 0, mr1 = 0;
  if (gw < nrows) { const float* s0; const float* s1; rowsrc(gw, true, s0, mr0); rowsrc(gw + NGW, gw + NGW < nrows, s1, mr1);
#pragma unroll
    for (int j = 0; j < 4; ++j) { v0[j] = ((const f32x4*)s0 + lane)[64 * j]; v1[j] = ((const f32x4*)s1 + lane)[64 * j]; } }
  for (int row0 = gw; row0 < nrows; row0 += 2 * NGW) {
    const int row1 = row0 + NGW; const bool has1 = row1 < nrows;
    const int nr0 = row0 + 2 * NGW, nr1 = nr0 + NGW; f32x4 n0[4], n1[4]; int nm0 = 0, nm1 = 0;
    if (nr0 < nrows) { const float* s0; const float* s1; rowsrc(nr0, true, s0, nm0); rowsrc(nr1, nr1 < nrows, s1, nm1);
#pragma unroll
      for (int j = 0; j < 4; ++j) { n0[j] = ((const f32x4*)s0 + lane)[64 * j]; n1[j] = ((const f32x4*)s1 + lane)[64 * j]; } }
    float s0 = 0.f, s1 = 0.f;
#pragma unroll
    for (int j = 0; j < 4; ++j) { s0 += (v0[j][0] * v0[j][0] + v0[j][1] * v0[j][1]) + (v0[j][2] * v0[j][2] + v0[j][3] * v0[j][3]); s1 += (v1[j][0] * v1[j][0] + v1[j][1] * v1[j][1]) + (v1[j][2] * v1[j][2] + v1[j][3] * v1[j][3]); }
    const float rs0 = rsqrtf(wave_sum(s0) * (1.f / 1024.f) + EPS), rs1 = rsqrtf(wave_sum(s1) * (1.f / 1024.f) + EPS);
    const float* m0 = mod + mr0 * 6144; const float* m1 = mod + mr1 * 6144; u32x2* o0 = (u32x2*)(H + (size_t)row0 * 1024) + lane; u32x2* o1 = (u32x2*)(H + (size_t)row1 * 1024) + lane;
#pragma unroll
    for (int j = 0; j < 4; ++j) { const int c0 = 256 * j + 4 * lane; const f32x4 gg = *(const f32x4*)(g + c0);
      { const f32x4 sc = *(const f32x4*)(m0 + scoff + c0), sh = *(const f32x4*)(m0 + shoff + c0); const f32x4 y = v0[j] * rs0 * gg * (sc + 1.f) + sh; u32x2 w; w.x = pk2(y[0], y[1]); w.y = pk2(y[2], y[3]); o0[64 * j] = w; }
      if (has1) { const f32x4 sc = *(const f32x4*)(m1 + scoff + c0), sh = *(const f32x4*)(m1 + shoff + c0); const f32x4 y = v1[j] * rs1 * gg * (sc + 1.f) + sh; u32x2 w; w.x = pk2(y[0], y[1]); w.y = pk2(y[2], y[3]); o1[64 * j] = w; } }
#pragma unroll
    for (int j = 0; j < 4; ++j) { v0[j] = n0[j]; v1[j] = n1[j]; }
    mr0 = nm0; mr1 = nm1;
  }
}

#define LAS __attribute__((address_space(3)))
#define XB_TMO      128
#define XB_XCNT(j)  (256  + 64 * (j))
#define XB_XSUB(j)  (1280 + 64 * (j))
#define XB_XGEN(j)  (2304 + 64 * (j))
#define XB_TOP      3328
#define XB_TOPGEN   3392
#define XCD_BAR_WORDS 3456
#define XB_SPIN_CAP (1u << 18)

__device__ __forceinline__ unsigned xb_ld(unsigned* p)              { return __hip_atomic_load(p, __ATOMIC_RELAXED, __HIP_MEMORY_SCOPE_AGENT); }
__device__ __forceinline__ unsigned xb_add(unsigned* p, unsigned v) { return __hip_atomic_fetch_add(p, v, __ATOMIC_RELAXED, __HIP_MEMORY_SCOPE_AGENT); }
__device__ __forceinline__ unsigned xb_xcc_id() { return (unsigned)__builtin_amdgcn_s_getreg((3 << 11) | 20) & 0xFu; }
#define XB_SPIN(cond, bar) do { unsigned _sp = 0; while (cond) { __builtin_amdgcn_s_sleep(1); \
    if ((++_sp & 255u) == 0u) { if (xb_ld(&(bar)[XB_TMO])) break; if (_sp > XB_SPIN_CAP) { atomicAdd(&(bar)[XB_TMO], 1u); break; } } } } while (0)

struct XcdBarrier {
    unsigned* bar; unsigned x;
    volatile LAS unsigned* st;
};

__device__ __forceinline__ XcdBarrier xcd_barrier_post(unsigned* bar, volatile LAS unsigned* st) {
    XcdBarrier b; b.bar = bar; b.x = xb_xcc_id(); b.st = st;
    if (threadIdx.x == 0) (void)xb_add(&bar[XB_XCNT(b.x)], 1u);
    return b;
}
__device__ __forceinline__ void xcd_barrier_complete(unsigned* bar, unsigned x, unsigned& nloc, unsigned& nx) {
    const unsigned G = gridDim.x * gridDim.y * gridDim.z;
    unsigned sum, cnt, mine, sp = 0u;
    for (;;) {
        sum = 0u; cnt = 0u; mine = 0u;
#pragma unroll
        for (unsigned j = 0; j < 16; ++j) { const unsigned c = xb_ld(&bar[XB_XCNT(j)]); sum += c; cnt += (c > 0u) ? 1u : 0u; mine = (j == x) ? c : mine; }
        if (sum == G) break;
        __builtin_amdgcn_s_sleep(1);
        if ((++sp & 255u) == 0u) { if (xb_ld(&bar[XB_TMO])) break; if (sp > XB_SPIN_CAP) { atomicAdd(&bar[XB_TMO], 1u); break; } }
    }
    nloc = mine > 0u ? mine : 1u; nx = cnt > 0u ? cnt : 1u;
}

__device__ __forceinline__ void xcd_barrier(const XcdBarrier& b) {
    asm volatile("s_waitcnt vmcnt(0)" ::: "memory");
    __syncthreads();
    if (threadIdx.x == 0) {
        unsigned* bar = b.bar;
        __builtin_amdgcn_s_waitcnt(0);
        unsigned nloc = b.st[0], nx = b.st[1];
        if (nloc == 0u) { xcd_barrier_complete(bar, b.x, nloc, nx); b.st[0] = nloc; b.st[1] = nx; }
        const unsigned old = xb_add(&bar[XB_XSUB(b.x)], 1u);
        const unsigned gen = old / nloc;
        if (old + 1u == (gen + 1u) * nloc) {
            __builtin_amdgcn_fence(__ATOMIC_RELEASE, "agent");
            asm volatile("s_waitcnt vmcnt(0)" ::: "memory");
            const unsigned og = xb_add(&bar[XB_TOP], 1u);
            const unsigned tg = og / nx;
            if (og + 1u == (tg + 1u) * nx) xb_add(&bar[XB_TOPGEN], 1u);
            else XB_SPIN(xb_ld(&bar[XB_TOPGEN]) == tg, bar);
            __builtin_amdgcn_fence(__ATOMIC_ACQUIRE, "agent");
            xb_add(&bar[XB_XGEN(b.x)], 1u);
            asm volatile("s_waitcnt vmcnt(0)" ::: "memory");
        } else {
            XB_SPIN(xb_ld(&bar[XB_XGEN(b.x)]) == gen, bar);
            __builtin_amdgcn_fence(__ATOMIC_ACQUIRE, "agent");
            asm volatile("s_waitcnt vmcnt(0)" ::: "memory");
        }
    }
    __syncthreads();
}

#ifndef PROBE_MASK
#define PROBE_MASK 0
#endif
#define NREP(x) (((PROBE_MASK >> (x)) & 1) ? 2 : 1)
#ifndef ONLY_PH
#define ONLY_PH -1
#endif
#define PHX(x) (ph_lo <= (x) && (x) <= ph_hi && (ONLY_PH < 0 || ONLY_PH == (x)))
#define PHSYNC(x) do { if (ph_lo <= (x) && (x) < ph_hi) { if (ph_hi >= 1000) grid.sync(); else xcd_barrier(xbar); } } while (0)
enum { PH_PRO = 0, PH_HN, PH_G1, PH_QKV, PH_SCAN, PH_SSMO, PH_GLU, PH_ATT, PH_WO, PH_WOUT, PH_HN2, PH_UP, PH_DOWN, PH_COUNT };
__global__ void __launch_bounds__(512, 2) mega(Params p) {
  extern __shared__ __attribute__((aligned(16))) unsigned char lds[];
  cg::grid_group grid = cg::this_grid();
  char* ws = p.ws; const int G = gridDim.x, blk = blockIdx.x, ph_lo = p.ph_lo, ph_hi = p.ph_hi;
  PG8_LAS unsigned char* ring = (PG8_LAS unsigned char*)lds;
  float* mod = (float*)(ws + WS_MOD);
  volatile LAS unsigned* bst = (volatile LAS unsigned*)((LAS unsigned char*)lds + 131072 + 12288);
  if (threadIdx.x < 2) bst[threadIdx.x] = 0u;
  __syncthreads();
  const XcdBarrier xbar = xcd_barrier_post((unsigned*)(ws + WS_BAR), bst);
  {
    if (PHX(PH_PRO)) for (int rep_ = 0; rep_ < NREP(PH_PRO); ++rep_) phase_pro(p, lds);
    PHSYNC(PH_PRO);
    if (PHX(PH_HN)) { phase_norm(p.in[I_X], p.in[I_CTX], p.in[I_N1G], mod, 0, 1024, (bf16_t*)(ws + WS_H), MALL);
      { const int lane = threadIdx.x & 63; const bf16_t* WU = (const bf16_t*)(ws + WS_WUP); float* B2 = (float*)(ws + WS_BIAS2);
        for (int r = blk * 8 + (threadIdx.x >> 6); r < 5632; r += G * 8) { float wv[16]; unpack8(*(const u32x4*)(WU + (size_t)r * 1024 + lane * 16), *(float(*)[8])&wv[0]); unpack8(*(const u32x4*)(WU + (size_t)r * 1024 + lane * 16 + 8), *(float(*)[8])&wv[8]);
#pragma unroll
          for (int bb_ = 0; bb_ < 4; ++bb_) { float a_ = 0.f;
#pragma unroll
            for (int e = 0; e < 16; ++e) a_ += wv[e] * mod[bb_ * 6144 + 3072 + lane * 16 + e];
            a_ = wave_sum(a_); if (lane == 0) B2[bb_ * 5632 + r] = a_; } } } }
    PHSYNC(PH_HN);
    if (PHX(PH_G1)) for (int rep_ = 0; rep_ < NREP(PH_G1); ++rep_) {
      pg8::Gemm g{1024, 1024, 1024}; InOrder S; S.T.init(ws + WS_H, 1024, ws + WS_WIN, 1024, NTOK, WIN_N, G, blk); S.G = G; S.c = blk; S.A = ws + WS_H; S.B = ws + WS_WIN;
      EpiIn E{(bf16_t*)(ws + WS_CQ), (bf16_t*)(ws + WS_CKV), (bf16_t*)(ws + WS_KR), (bf16_t*)(ws + WS_UA), (bf16_t*)(ws + WS_GL), (float*)(ws + WS_RSQ), (float*)(ws + WS_RSK), (float*)(ws + WS_RSR)};
      pg8::gemm_phase<EpiIn, InOrder, true, true>(ring, g, S, E);
    }
    PHSYNC(PH_G1);
    if (PHX(PH_QKV)) for (int rep_ = 0; rep_ < NREP(PH_QKV); ++rep_) {
      const float* rope = (const float*)(ws + WS_ROPE); float* ex = (float*)(lds + 131072);
#ifndef NO_Q
      { int kq = QL; asm volatile("" : "+s"(kq));
        pg8::Gemm g{kq, QL, QL}; pg8::TileOrder S; S.init(ws + WS_CQ, QL, ws + WS_WUQ, QL, NTOK, 1024, G, blk);
        EpiQ E{(const float*)(ws + WS_RSQ), p.in[I_QNG], rope, (bf16_t*)(ws + WS_Q), ex};
#ifdef Q_TRIV
        EpiS E2{(float*)(ws + WS_S)}; pg8::gemm_phase<EpiS, pg8::TileOrder, true, true>(ring, g, S, E2); }
#else
        pg8::gemm_phase<EpiQ, pg8::TileOrder, true, true>(ring, g, S, E); }
#endif
#endif
#ifndef NO_KV
      { int kk = KVL; asm volatile("" : "+s"(kk));
        pg8::Gemm g{kk, KVL, KVL}; pg8::TileOrder S; S.init(ws + WS_CKV, KVL, ws + WS_WUKV, KVL, NTOK, 1024, G, blk);
        EpiKV E{(const float*)(ws + WS_RSK), (const float*)(ws + WS_RSR), (const bf16_t*)(ws + WS_KR), p.in[I_KNG], rope, (bf16_t*)(ws + WS_K), (bf16_t*)(ws + WS_V), ex};
        pg8::gemm_phase<EpiKV, pg8::TileOrder, true, true>(ring, g, S, E); }
#endif
#ifndef NO_S
      { pg8::Gemm g{512, UA_K, 512}; SOrder S{G, blk, ws + WS_UA, ws + WS_W1}; EpiS E{(float*)(ws + WS_S)};
        pg8::gemm_phase<EpiS, SOrder, true, true>(ring, g, S, E); }
#endif
      { int kk = KVL; asm volatile("" : "+s"(kk));
        pg8::Gemm g{kk, KVL, KVL}; CtxOrder S{G, blk, ws + WS_CKV, ws + WS_WUKV};
        EpiKV E{(const float*)(ws + WS_RSK), (const float*)(ws + WS_RSR), (const bf16_t*)(ws + WS_KR), p.in[I_KNG], rope, (bf16_t*)(ws + WS_K), (bf16_t*)(ws + WS_V), ex};
        pg8::gemm_phase<EpiKV, CtxOrder, true, true>(ring, g, S, E); }
    }
    PHSYNC(PH_QKV);
    if (PHX(PH_SCAN)) for (int rep_ = 0; rep_ < NREP(PH_SCAN); ++rep_) {
      float* seg = (float*)lds;
      for (int task = blk; task < NB * NG * 2; task += G) {
        const int n = threadIdx.x & 63, w = threadIdx.x >> 6, dir = task & 1, g = (task >> 1) & 31, b = task >> 6;
        const float* Sp = (const float*)(ws + WS_S) + (size_t)g * UA_ROWS * 256 + dir * 128 + n;
        bf16_t* X = (bf16_t*)(ws + WS_UA) + (size_t)g * UA_ROWS * UA_K + 512 + dir * 128 + n;
        const float* AL = (const float*)(ws + WS_AL); const float alr = AL[((g * 2 + dir) * 64 + n) * 2], ali = AL[((g * 2 + dir) * 64 + n) * 2 + 1];
        float sr[33], si[33];
#pragma unroll
        for (int i = 0; i < 33; ++i) { const int q = 33 * w + i; const int row = q < NCHC ? NB * NCHL + b * NCHC + (dir ? NCHC - 1 - q : q) : b * NCHL + (dir ? NCHL - 1 - (q - NCHC) : (q - NCHC));
          sr[i] = Sp[(size_t)row * 256]; si[i] = Sp[(size_t)row * 256 + 64]; }
        float xr = 0.f, xi = 0.f, pr = 1.f, pi = 0.f;
#pragma unroll
        for (int i = 0; i < 33; ++i) { const float t = alr * xr - ali * xi + sr[i]; xi = alr * xi + ali * xr + si[i]; xr = t; const float u = alr * pr - ali * pi; pi = alr * pi + ali * pr; pr = u; }
        seg[(w * 64 + n) * 2] = xr; seg[(w * 64 + n) * 2 + 1] = xi;
        __syncthreads();
        xr = 0.f; xi = 0.f;
        for (int v = 0; v < w; ++v) { const float br = seg[(v * 64 + n) * 2], bi = seg[(v * 64 + n) * 2 + 1]; const float t = pr * xr - pi * xi + br; xi = pr * xi + pi * xr + bi; xr = t; }
#pragma unroll
        for (int i = 0; i < 33; ++i) { const int q = 33 * w + i;
          if (q >= NCHC) { const int row = b * NCHL + (dir ? NCHL - 1 - (q - NCHC) : (q - NCHC)); X[(size_t)row * UA_K] = f2bf(xr); X[(size_t)row * UA_K + 64] = f2bf(xi); }
          const float t = alr * xr - ali * xi + sr[i]; xi = alr * xi + ali * xr + si[i]; xr = t; }
        __syncthreads();
      }
    }
    PHSYNC(PH_SCAN);
    if (PHX(PH_SSMO)) for (int rep_ = 0; rep_ < NREP(PH_SSMO); ++rep_) {
      pg8::Gemm g{UA_K, UA_K, UA_K}; YOrder S{G, blk, ws + WS_UA, ws + WS_WT}; EpiY E{(bf16_t*)(ws + WS_GY)};
      pg8::gemm_phase<EpiY, YOrder, true, true>(ring, g, S, E);
    }
    PHSYNC(PH_SSMO);
    if (PHX(PH_GLU)) for (int rep_ = 0; rep_ < NREP(PH_GLU); ++rep_) {
      pg8::Gemm g{512, 512, 512}; pg8::TileOrder S; S.init(ws + WS_GY, 512, ws + WS_WGLU, 512, NTOK, 2048, G, blk);
      EpiGlu E{(const bf16_t*)(ws + WS_GL), (bf16_t*)(ws + WS_MS)};
      pg8::gemm_phase<EpiGlu, pg8::TileOrder, true, true>(ring, g, S, E);
    }
    if (PHX(PH_ATT)) for (int rep_ = 0; rep_ < NREP(PH_ATT); ++rep_) {
      const bool fastsm = *(const float*)(ws + WS_LBOUND) <= 64.f;
      for (int un = blk; un < NB * NH * (SEQ / 256); un += G) {
        const int x = un & 7, rest = un >> 3, qb = rest & 31, bh = x * 4 + (rest >> 5), b = bh >> 3, h = bh & 7;
        if (fastsm) att::attn_unit<true>((const bf16_t*)(ws + WS_Q) + ((size_t)bh * SEQ + qb * 256) * QKD, (const bf16_t*)(ws + WS_K) + (size_t)bh * SKV * KP, (const bf16_t*)(ws + WS_V) + (size_t)bh * SKV * VD,
                       (bf16_t*)(ws + WS_O) + ((size_t)(b * SEQ + qb * 256)) * AW + h * VD, SKV, (char*)lds);
        else att::attn_unit<false>((const bf16_t*)(ws + WS_Q) + ((size_t)bh * SEQ + qb * 256) * QKD, (const bf16_t*)(ws + WS_K) + (size_t)bh * SKV * KP, (const bf16_t*)(ws + WS_V) + (size_t)bh * SKV * VD,
                       (bf16_t*)(ws + WS_O) + ((size_t)(b * SEQ + qb * 256)) * AW + h * VD, SKV, (char*)lds);
      }
    }
    PHSYNC(PH_ATT);
    if (PHX(PH_WO)) for (int rep_ = 0; rep_ < NREP(PH_WO); ++rep_) {
      pg8::Gemm g{512, 512, 512}; pg8::TileOrder S; S.init(ws + WS_O, 512, ws + WS_WO, 512, NTOK, 1024, G, blk);
      EpiWo E{(const bf16_t*)(ws + WS_GL), (const bf16_t*)(ws + WS_MS), (bf16_t*)(ws + WS_MM)};
      pg8::gemm_phase<EpiWo, pg8::TileOrder, true, true>(ring, g, S, E);
    }
    PHSYNC(PH_WO);
    if (PHX(PH_WOUT)) for (int rep_ = 0; rep_ < NREP(PH_WOUT); ++rep_) {
      pg8::Gemm g{1024, 1024, 1024}; pg8::TileOrder S; S.init(ws + WS_MM, 1024, ws + WS_WOUT, 1024, NTOK, 1024, G, blk);
      EpiRes2 E{p.in[I_X], mod, p.in[I_N2G], p.out, (bf16_t*)(ws + WS_H2), (float*)(ws + WS_RS2)};
      pg8::gemm_phase<EpiRes2, pg8::TileOrder, true, true>(ring, g, S, E);
    }
    PHSYNC(PH_WOUT);
    if (PHX(PH_UP)) for (int rep_ = 0; rep_ < NREP(PH_UP); ++rep_) {
      pg8::Gemm g{1024, 1024, 1024}; UpOrder S; S.T.init(ws + WS_H2, 1024, ws + WS_WUP, 1024, 132 * 256, 5632, G, blk); S.A = ws + WS_H2;
      EpiUp E{p.in[I_CONVW], p.in[I_CONVB], (bf16_t*)(ws + WS_ACT), (float*)(lds + 131072), (const float*)(ws + WS_RS2), (const float*)(ws + WS_BIAS2)};
      pg8::gemm_phase<EpiUp, UpOrder, true, true>(ring, g, S, E);
    }
    PHSYNC(PH_UP);
    if (PHX(PH_DOWN)) for (int rep_ = 0; rep_ < NREP(PH_DOWN); ++rep_) {
      pg8::Gemm g{FH, FH, FH}; pg8::TileOrder S; S.init(ws + WS_ACT, FH, ws + WS_WDN, FH, NTOK, 1024, G, blk);
      EpiRes E{p.out, mod, 5120, p.out};
      pg8::gemm_phase<EpiRes, pg8::TileOrder, true, true>(ring, g, S, E);
    }
  }
}

extern "C" void kernel_launch(void* const* d_in, const int* in_sizes, int n_in, void* d_out, int out_size, void* d_ws, size_t ws_size, hipStream_t stream) {
  static int grid = 0;
  if (grid == 0) {
    if (n_in != 35 || ws_size < WS_NEED) { fprintf(stderr, "kernel_launch: bad args n_in %d ws %zu\n", n_in, ws_size); grid = -1; return; }
    int dev = 0, cus = 0, per_cu = 0;
    hipGetDevice(&dev); hipDeviceGetAttribute(&cus, hipDeviceAttributeMultiprocessorCount, dev);
    if (hipFuncSetAttribute((const void*)mega, hipFuncAttributeMaxDynamicSharedMemorySize, LDS_BYTES) != hipSuccess) { fprintf(stderr, "kernel_launch: hipFuncSetAttribute failed\n"); grid = -1; return; }
    if (hipOccupancyMaxActiveBlocksPerMultiprocessor(&per_cu, (const void*)mega, 512, LDS_BYTES) != hipSuccess || per_cu < 1) { fprintf(stderr, "kernel_launch: occupancy query failed (%d)\n", per_cu); grid = -1; return; }
    grid = cus * per_cu;
    fprintf(stderr, "kernel_launch: cus %d per_cu %d grid %d\n", cus, per_cu, grid);
  }
  if (grid < 0) return;
  Params p{};
  for (int i = 0; i < 35; ++i) p.in[i] = (const float*)d_in[i];
  p.out = (float*)d_out; p.ws = (char*)d_ws;
  char* ws = (char*)d_ws; float* out = (float*)d_out;
  float* rope = (float*)(ws + WS_ROPE);
  bf16_t* H2 = (bf16_t*)(ws + WS_H2); float* Y = (float*)(ws + WS_Y);
  bf16_t* CQ = (bf16_t*)(ws + WS_CQ); bf16_t* CKV = (bf16_t*)(ws + WS_CKV); bf16_t* KR = (bf16_t*)(ws + WS_KR); bf16_t* GY = (bf16_t*)(ws + WS_GY);
  bf16_t* UA = (bf16_t*)(ws + WS_UA); bf16_t* O = (bf16_t*)(ws + WS_O); bf16_t* Q = (bf16_t*)(ws + WS_Q); bf16_t* ACT = (bf16_t*)(ws + WS_ACT);
  bf16_t* Kb = (bf16_t*)(ws + WS_K); bf16_t* Vb = (bf16_t*)(ws + WS_V);
  const float** in = p.in;
#define MEGA(lo, hi) do { p.ph_lo = (lo); p.ph_hi = (hi); if ((lo) == (hi)) hipLaunchKernelGGL(mega, dim3(grid), dim3(512), LDS_BYTES, stream, p); \
    else { void* args[] = {&p}; hipError_t e = hipLaunchCooperativeKernel((const void*)mega, dim3(grid), dim3(512), args, LDS_BYTES, stream); if (e != hipSuccess) fprintf(stderr, "cooperative launch failed: %s\n", hipGetErrorString(e)); } } while (0)
  if (hipMemsetAsync((char*)d_ws + WS_BAR, 0, 16384, stream) != hipSuccess) { fprintf(stderr, "kernel_launch: memset failed\n"); return; }
  MEGA(PH_PRO, PH_DOWN);
  (void)out;
}
```

```cpp
#include <hip/hip_runtime.h>
#include <hip/hip_cooperative_groups.h>
#include <cstdio>
#include <cstdint>
#include <cmath>
namespace cg = cooperative_groups;

typedef unsigned short bf16_t;
typedef short bf16x8 __attribute__((ext_vector_type(8)));
typedef float f32x4 __attribute__((ext_vector_type(4)));
typedef unsigned u32x4 __attribute__((ext_vector_type(4)));
typedef unsigned u32x2 __attribute__((ext_vector_type(2)));
__device__ __forceinline__ float bf2f(bf16_t v) { return __uint_as_float(((unsigned)v) << 16); }
__device__ __forceinline__ bf16_t f2bf(float f) { unsigned u = __float_as_uint(f); return (bf16_t)((u + 0x7fffu + ((u >> 16) & 1u)) >> 16); }
__device__ __forceinline__ unsigned pk2(float lo, float hi) { unsigned r; asm volatile("v_cvt_pk_bf16_f32 %0, %1, %2" : "=v"(r) : "v"(lo), "v"(hi)); return r; }
__device__ __forceinline__ float lo16(unsigned w) { return __uint_as_float(w << 16); }
__device__ __forceinline__ float hi16(unsigned w) { return __uint_as_float(w & 0xffff0000u); }
__device__ __forceinline__ float sigmoidf_(float v) { return __builtin_amdgcn_rcpf(1.f + __builtin_amdgcn_exp2f(-1.4426950408889634f * v)); }
__device__ __forceinline__ float gelu_tanh(float v) { const float u = 0.7978845608028654f * (v + 0.044715f * v * v * v); return v * sigmoidf_(2.f * u); }
__device__ __forceinline__ float fq_sum(float v) {
  auto a = __builtin_amdgcn_permlane16_swap(__float_as_uint(v), __float_as_uint(v), false, false); v = __uint_as_float(a[0]) + __uint_as_float(a[1]);
  auto b = __builtin_amdgcn_permlane32_swap(__float_as_uint(v), __float_as_uint(v), false, false); return __uint_as_float(b[0]) + __uint_as_float(b[1]);
}
__device__ __forceinline__ float xor32(float v, bool lower) {
  auto b = __builtin_amdgcn_permlane32_swap(__float_as_uint(v), __float_as_uint(v), false, false); return lower ? __uint_as_float(b[1]) : __uint_as_float(b[0]);
}
__device__ __forceinline__ float wave_sum(float v) {
#pragma unroll
  for (int o = 1; o < 64; o <<= 1) v += __shfl_xor(v, o);
  return v;
}

constexpr int D = 1024, NB = 4, SEQ = 8192, CTX = 256, NTOK = NB * SEQ, NCTX = NB * CTX, MALL = NTOK + NCTX;
constexpr int NH = 8, QKD = 96, VD = 64, QL = 384, KVL = 256, AW = 512;
constexpr int SW = 512, NG = 32, SN = 64, FH = 2816, INW = 3232;
constexpr int SKV = SEQ + CTX;
constexpr int KP = 128;
constexpr int CL = 32;
constexpr int NCHL = SEQ / CL, NCHC = CTX / CL;
constexpr int UA_ROWS = 1280, UA_K = 768;
constexpr float EPS = 1e-6f;
constexpr float QSCALE = 0.10206207261596577f * 1.4426950408889634f;
constexpr int WIN_N = 3328;

constexpr size_t MiB = 1u << 20;
constexpr size_t WS_MOD = 0;
constexpr size_t WS_AL = 256 * 1024;
constexpr size_t WS_RSQ = 384 * 1024, WS_RSK = WS_RSQ + 135168, WS_RSR = WS_RSK + 135168;
constexpr size_t WS_BAR = 832 * 1024;
constexpr size_t WS_LBOUND = 320 * 1024;
constexpr size_t WS_ROPE = 1 * MiB;
constexpr size_t WS_WIN = 2 * MiB;
constexpr size_t WS_WUQ = 9 * MiB;
constexpr size_t WS_WUKV = 10 * MiB;
constexpr size_t WS_WO = 11 * MiB;
constexpr size_t WS_WGLU = 12 * MiB;
constexpr size_t WS_WOUT = 14 * MiB;
constexpr size_t WS_WUP = 16 * MiB;
constexpr size_t WS_WDN = 27 * MiB;
constexpr size_t WS_WT = 33 * MiB;
constexpr size_t WS_W1 = 57 * MiB;
constexpr size_t WS_H = 66 * MiB;
constexpr size_t WS_MS = 66 * MiB;
constexpr size_t WS_H2 = 66 * MiB;
constexpr size_t WS_Y = 66 * MiB;
constexpr size_t WS_S = 66 * MiB;
constexpr size_t WS_CQ = 132 * MiB;
constexpr size_t WS_CKV = 156 * MiB;
constexpr size_t WS_KR = 173 * MiB;
constexpr size_t WS_GY = 132 * MiB;
constexpr size_t WS_MM = 132 * MiB;
constexpr size_t WS_UA = 176 * MiB;
constexpr size_t WS_O = 196 * MiB;
constexpr size_t WS_GL = 236 * MiB;
constexpr size_t WS_Q = 364 * MiB;
constexpr size_t WS_ACT = 236 * MiB;
constexpr size_t WS_K = 412 * MiB;
constexpr size_t WS_V = 478 * MiB;
constexpr size_t WS_NEED = 511 * MiB;

namespace pg8 {
#define PG8_LAS __attribute__((address_space(3)))
constexpr int BM = 256, BK = 64, HALF = 128, HTB = HALF * BK * 2  , STAGE_BYTES = 8 * HTB, NXCD = 8, WGM = 8;
__host__ __device__ __forceinline__ int lds_byte(int r, int c) { const int st = (r >> 4) * 2 + (c >> 5), rr = r & 15, cc = c & 31, ob = rr * 64 + cc * 2; return st * 1024 + (ob ^ (((ob >> 9) & 1) << 5)); }
__host__ __device__ __forceinline__ void stage_rc(int b, int& R, int& C) { const int st = b / 1024, sb = b % 1024, swz = sb ^ (((sb >> 9) & 1) << 5); R = (st >> 1) * 16 + swz / 64; C = (st & 1) * 32 + (swz % 64) / 2; }
__host__ __device__ __forceinline__ int perm32(int rho) { const int n = rho >> 4, i = rho & 15; return 8 * (i >> 2) + 4 * n + (i & 3); }

struct Unit { int pm, pn; const char* a; const char* b; };
struct Gemm { int K, lda, ldb; };

struct TileOrder {
    int nM, nN, nwg, G, c; const char* A; const char* B; size_t tsA, tsB;
    __device__ void init(const void* A_, int lda, const void* B_, int ldb, int M, int N, int G_, int c_) { nM = M / BM; nN = N / BM; nwg = nM * nN; G = G_; c = c_; A = (const char*)A_; B = (const char*)B_; tsA = (size_t)BM * lda * 2; tsB = (size_t)BM * ldb * 2; }
    __device__ bool next(int i, Unit& u) const {
        const long L = (long)i * G + c; if (L >= nwg) return false;
        int wgid = (int)L; { const int q = nwg / NXCD, r = nwg % NXCD, xcd = wgid % NXCD, off = wgid / NXCD; wgid = (xcd < r ? xcd * (q + 1) : r * (q + 1) + (xcd - r) * q) + off; }
        const int nig = WGM * nN, gid = wgid / nig, fm = gid * WGM, gsz = (nM - fm) < WGM ? (nM - fm) : WGM;
        u.pm = fm + ((wgid % nig) % gsz); u.pn = (wgid % nig) / gsz; u.a = A + (size_t)u.pm * tsA; u.b = B + (size_t)u.pn * tsB; return true;
    }
};
template <class Epi, class Sched, bool ALIGN_EPI = false, bool SP2 = false>
__device__ __forceinline__ void gemm_phase(PG8_LAS unsigned char* lds, const Gemm g, const Sched& S, const Epi& E) {
    int tid_ = threadIdx.x; asm volatile("" : "+v"(tid_));
    const int tid = tid_, wid = __builtin_amdgcn_readfirstlane(tid >> 6), lane = tid & 63, wr = wid >> 2, wc = wid & 3, fr = lane & 15, fq = lane >> 4;
    const int K = g.K, nt = K / BK;
    unsigned voffA[2], voffB[2];
#pragma unroll
    for (int i = 0; i < 2; ++i) { int R, C; stage_rc(tid * 16 + i * 8192, R, C); const int Rb = Epi::PERM ? ((R & ~31) + perm32(R & 31)) : R;
        voffA[i] = (unsigned)(R * g.lda + C) * 2u; voffB[i] = (unsigned)(Rb * g.ldb + C) * 2u; }
    const size_t kstep = (size_t)(BK * 2);
    const size_t hstepA = (size_t)HALF * g.lda * 2, hstepB = (size_t)HALF * g.ldb * 2;
    const unsigned ldsw = (unsigned)wid * 1024u;
    const int aoff = lds_byte(wr * 64 + fr, fq * 8), boff = lds_byte(wc * 32 + fr, fq * 8);
#define PG8_SA(b, h) (((b) * 2 + (h)) * HTB)
#define PG8_SB(b, h) ((4 + (b) * 2 + (h)) * HTB)
#define PG8_STAGE(bufoff, gbase, voff) do { _Pragma("unroll") for (int _i = 0; _i < 2; ++_i) \
        __builtin_amdgcn_global_load_lds((const unsigned*)((const char*)(gbase) + (voff)[_i]), (PG8_LAS unsigned*)(lds + (bufoff) + ldsw + _i * 8192), 16, 0, 0); } while (0)
#define PG8_LDA(dst, b, h) do { _Pragma("unroll") for (int m = 0; m < 4; ++m) _Pragma("unroll") for (int k = 0; k < 2; ++k) dst[m][k] = *(const PG8_LAS bf16x8*)(lds + PG8_SA(b, h) + aoff + m * 2048 + k * 1024); } while (0)
#define PG8_LDB(dst, b, h) do { _Pragma("unroll") for (int n = 0; n < 2; ++n) _Pragma("unroll") for (int k = 0; k < 2; ++k) dst[n][k] = *(const PG8_LAS bf16x8*)(lds + PG8_SB(b, h) + boff + n * 2048 + k * 1024); } while (0)
#define PG8_MMA(ai, bj, At, Bt) do { __builtin_amdgcn_s_setprio(1); _Pragma("unroll") for (int m = 0; m < 4; ++m) _Pragma("unroll") for (int n = 0; n < 2; ++n) _Pragma("unroll") for (int k = 0; k < 2; ++k) \
        acc[ai][bj][m][n] = __builtin_amdgcn_mfma_f32_16x16x32_bf16(Bt[n][k], At[m][k], acc[ai][bj][m][n], 0, 0, 0); __builtin_amdgcn_s_setprio(0); } while (0)
#define PG8_WAIT_V(n) asm volatile("s_waitcnt vmcnt(" #n ")" ::: "memory")
#define PG8_WAIT_L(n) asm volatile("s_waitcnt lgkmcnt(" #n ")" ::: "memory")
#define PG8_BAR __builtin_amdgcn_s_barrier()
#define PG8_SCHED __builtin_amdgcn_sched_barrier(0)
    Unit cur, nxt; int ui = 0;
    if (!S.next(0, cur)) return;
    f32x4 acc[2][2][4][2];
#pragma unroll
    for (int a = 0; a < 2; ++a)
#pragma unroll
        for (int b = 0; b < 2; ++b)
#pragma unroll
            for (int m = 0; m < 4; ++m)
#pragma unroll
                for (int n = 0; n < 2; ++n) acc[a][b][m][n] = (f32x4){0.f, 0.f, 0.f, 0.f};
    bf16x8 At[4][2], B0[2][2], B1[2][2];
    const char* cA = cur.a; const char* cB = cur.b;
    if constexpr (SP2) {
        PG8_STAGE(PG8_SB(0, 0), cB, voffB); PG8_STAGE(PG8_SB(0, 1), cB + hstepB, voffB); PG8_STAGE(PG8_SA(0, 0), cA, voffA); PG8_STAGE(PG8_SA(0, 1), cA + hstepA, voffA);
        if (wr == 1) PG8_BAR;
        PG8_WAIT_V(2); PG8_BAR;
        PG8_STAGE(PG8_SB(1, 0), cB + kstep, voffB); PG8_STAGE(PG8_SA(1, 0), cA + kstep, voffA); PG8_STAGE(PG8_SB(1, 1), cB + hstepB + kstep, voffB);
        PG8_WAIT_V(6); PG8_BAR;
    } else {
        PG8_STAGE(PG8_SB(0, 0), cB, voffB); PG8_STAGE(PG8_SA(0, 0), cA, voffA); PG8_STAGE(PG8_SB(0, 1), cB + hstepB, voffB); PG8_STAGE(PG8_SA(0, 1), cA + hstepA, voffA);
        if (wr == 1) PG8_BAR;
        PG8_WAIT_V(4); PG8_BAR;
        PG8_STAGE(PG8_SB(1, 0), cB + kstep, voffB); PG8_STAGE(PG8_SA(1, 0), cA + kstep, voffA); PG8_STAGE(PG8_SB(1, 1), cB + hstepB + kstep, voffB);
        PG8_WAIT_V(6); PG8_BAR;
    }
    for (;;) {
        const bool has_next = S.next(ui + 1, nxt);
        const char* nA = has_next ? nxt.a : cA; const char* nB = has_next ? nxt.b : cB;
        for (int t = 0; t < nt; t += 2) {
            const bool last = (t == nt - 2);
            const char* a1 = cA + (size_t)(t + 1) * kstep;
            const char* a2 = last ? nA : cA + (size_t)(t + 2) * kstep; const char* b2 = last ? nB : cB + (size_t)(t + 2) * kstep;
            const char* a3 = a2 + kstep; const char* b3 = b2 + kstep;
            if constexpr (SP2) {
            PG8_LDB(B0, 0, 0); PG8_LDB(B1, 0, 1); PG8_SCHED; PG8_LDA(At, 0, 0); PG8_STAGE(PG8_SA(1, 1), a1 + hstepA, voffA);
            PG8_WAIT_V(8); PG8_WAIT_L(0); PG8_BAR; PG8_MMA(0, 0, At, B0); PG8_MMA(0, 1, At, B1); PG8_BAR; PG8_SCHED;
            PG8_LDA(At, 0, 1); PG8_STAGE(PG8_SB(0, 0), b2, voffB); PG8_STAGE(PG8_SB(0, 1), b2 + hstepB, voffB); PG8_STAGE(PG8_SA(0, 0), a2, voffA);
            PG8_WAIT_V(8); PG8_WAIT_L(0); PG8_BAR; PG8_MMA(1, 0, At, B0); PG8_MMA(1, 1, At, B1); PG8_BAR; PG8_SCHED;
            PG8_LDB(B0, 1, 0); PG8_LDB(B1, 1, 1); PG8_SCHED; PG8_LDA(At, 1, 0); PG8_STAGE(PG8_SA(0, 1), a2 + hstepA, voffA);
            PG8_WAIT_V(8); PG8_WAIT_L(0); PG8_BAR; PG8_MMA(0, 0, At, B0); PG8_MMA(0, 1, At, B1); PG8_BAR; PG8_SCHED;
            PG8_LDA(At, 1, 1); PG8_STAGE(PG8_SB(1, 0), b3, voffB); PG8_STAGE(PG8_SB(1, 1), b3 + hstepB, voffB); PG8_STAGE(PG8_SA(1, 0), a3, voffA);
            PG8_WAIT_V(8); PG8_WAIT_L(0); PG8_BAR; PG8_MMA(1, 0, At, B0); PG8_MMA(1, 1, At, B1); PG8_BAR; PG8_SCHED;
            } else {
            PG8_LDB(B0, 0, 0); PG8_SCHED; PG8_LDA(At, 0, 0); PG8_STAGE(PG8_SA(1, 1), a1 + hstepA, voffA);
            PG8_WAIT_L(8); PG8_BAR; PG8_WAIT_L(0); PG8_MMA(0, 0, At, B0); PG8_BAR; PG8_SCHED;
            PG8_LDB(B1, 0, 1); PG8_STAGE(PG8_SB(0, 0), b2, voffB);
            PG8_BAR; PG8_WAIT_L(0); PG8_MMA(0, 1, At, B1); PG8_BAR;
            PG8_LDA(At, 0, 1); PG8_STAGE(PG8_SA(0, 0), a2, voffA);
            PG8_BAR; PG8_WAIT_L(0); PG8_MMA(1, 0, At, B0); PG8_BAR; PG8_SCHED;
            PG8_STAGE(PG8_SB(0, 1), b2 + hstepB, voffB);
            PG8_WAIT_V(6); PG8_BAR; PG8_MMA(1, 1, At, B1); PG8_BAR;
            PG8_LDB(B0, 1, 0); PG8_SCHED; PG8_LDA(At, 1, 0); PG8_STAGE(PG8_SA(0, 1), a2 + hstepA, voffA);
            PG8_WAIT_L(8); PG8_BAR; PG8_WAIT_L(0); PG8_MMA(0, 0, At, B0); PG8_BAR; PG8_SCHED;
            PG8_LDB(B1, 1, 1); PG8_STAGE(PG8_SB(1, 0), b3, voffB);
            PG8_BAR; PG8_WAIT_L(0); PG8_MMA(0, 1, At, B1); PG8_BAR;
            PG8_LDA(At, 1, 1); PG8_STAGE(PG8_SA(1, 0), a3, voffA);
            PG8_BAR; PG8_WAIT_L(0); PG8_MMA(1, 0, At, B0); PG8_BAR; PG8_SCHED;
            PG8_STAGE(PG8_SB(1, 1), b3 + hstepB, voffB);
            PG8_WAIT_V(6); PG8_BAR; PG8_MMA(1, 1, At, B1); PG8_BAR;
            }
        }
        if constexpr (ALIGN_EPI) { if (wr == 0) PG8_BAR; }
        if constexpr (!Epi::AFTER_DRAIN) { E(acc, cur, wr, wc, fr, fq); }
        if (!has_next) break;
#pragma unroll
        for (int a = 0; a < 2; ++a)
#pragma unroll
            for (int b = 0; b < 2; ++b)
#pragma unroll
                for (int m = 0; m < 4; ++m)
#pragma unroll
                    for (int n = 0; n < 2; ++n) acc[a][b][m][n] = (f32x4){0.f, 0.f, 0.f, 0.f};
        cur = nxt; cA = nA; cB = nB; ++ui;
        if constexpr (ALIGN_EPI) { if (wr == 1) PG8_BAR; }
    }
    PG8_WAIT_V(0);
    if constexpr (!ALIGN_EPI) { if (wr == 0) PG8_BAR; }
    PG8_BAR;
    if constexpr (Epi::AFTER_DRAIN) { E.fused(acc, cur, wr, wc, fr, fq, lds, wid, lane); }
#undef PG8_SA
#undef PG8_SB
#undef PG8_STAGE
#undef PG8_LDA
#undef PG8_LDB
#undef PG8_MMA
#undef PG8_WAIT_V
#undef PG8_WAIT_L
#undef PG8_BAR
#undef PG8_SCHED
}
}
using pg8::Unit;

__device__ __forceinline__ u32x4 pack8(const f32x4 a, const f32x4 b) { u32x4 w; w.x = pk2(a[0], a[1]); w.y = pk2(a[2], a[3]); w.z = pk2(b[0], b[1]); w.w = pk2(b[2], b[3]); return w; }
__device__ __forceinline__ void unpack8(const u32x4 w, float (&o)[8]) { o[0] = lo16(w.x); o[1] = hi16(w.x); o[2] = lo16(w.y); o[3] = hi16(w.y); o[4] = lo16(w.z); o[5] = hi16(w.z); o[6] = lo16(w.w); o[7] = hi16(w.w); }

struct EpiIn {
  static constexpr bool PERM = true, AFTER_DRAIN = false;
  bf16_t *CQ, *CKV, *KR, *UA, *GL; float *RSQ, *RSK, *RSR;
  __device__ __forceinline__ void operator()(const f32x4 (&acc)[2][2][4][2], const Unit& u, int wr, int wc, int fr, int fq) const {
#pragma unroll
    for (int ai = 0; ai < 2; ++ai)
#pragma unroll
      for (int m = 0; m < 4; ++m) {
        const int row = u.pm * 256 + ai * 128 + wr * 64 + m * 16 + fr;
#pragma unroll
        for (int bj = 0; bj < 2; ++bj) {
          const int col = u.pn * 256 + bj * 128 + wc * 32 + 8 * fq;
          const u32x4 w = pack8(acc[ai][bj][m][0], acc[ai][bj][m][1]);
          if (col < 672) { const f32x4 a0 = acc[ai][bj][m][0], a1 = acc[ai][bj][m][1];
            float ss = (a0[0] * a0[0] + a0[1] * a0[1]) + (a0[2] * a0[2] + a0[3] * a0[3]) + (a1[0] * a1[0] + a1[1] * a1[1]) + (a1[2] * a1[2] + a1[3] * a1[3]);
            ss = fq_sum(ss);
            if (fq == 0) { if (col < 384) atomicAdd(RSQ + row, ss); else if (col < 640) atomicAdd(RSK + row, ss); else RSR[row] = ss; } }
          if (col < 384) { if (row < NTOK) *(u32x4*)(CQ + (size_t)row * 384 + col) = w; }
          else if (col < 640) *(u32x4*)(CKV + (size_t)row * 256 + (col - 384)) = w;
          else if (col < 672) *(u32x4*)(KR + (size_t)row * 32 + (col - 640)) = w;
          else if (col < 1184) { const int j = col - 672, g = j >> 4, jj = j & 15; int crow, s;
            if (row < NTOK) { const int b = row / SEQ, t = row % SEQ; crow = b * NCHL + t / CL; s = t % CL; }
            else { const int mc = row - NTOK, b = mc / CTX, t = mc % CTX; crow = NB * NCHL + b * NCHC + t / CL; s = t % CL; }
            *(u32x4*)(UA + ((size_t)g * UA_ROWS + crow) * UA_K + s * 16 + jj) = w; }
          else if (col < 1280) { }
          else { if (row < NTOK) *(u32x4*)(GL + (size_t)row * 2048 + (col - 1280)) = w; }
        }
      }
  }
};
struct EpiGlu {
  static constexpr bool PERM = true, AFTER_DRAIN = false;
  const bf16_t* GL; bf16_t* MS;
  __device__ __forceinline__ void operator()(const f32x4 (&acc)[2][2][4][2], const Unit& u, int wr, int wc, int fr, int fq) const {
    const int col = u.pn * 128 + wc * 32 + 8 * fq, row0 = u.pm * 256 + wr * 64 + fr;
    u32x4 buf[2][4];
#define GLU_LOAD(ai, d) do { _Pragma("unroll") for (int m = 0; m < 4; ++m) d[m] = *(const u32x4*)(GL + (size_t)(row0 + (ai) * 128 + m * 16) * 2048 + 1024 + col); } while (0)
#define GLU_DO(ai, d) do { _Pragma("unroll") for (int m = 0; m < 4; ++m) { float gs[8]; unpack8(d[m], gs); f32x4 o0, o1; \
      _Pragma("unroll") for (int e = 0; e < 4; ++e) { o0[e] = sigmoidf_(gs[e]) * acc[ai][0][m][0][e] * sigmoidf_(acc[ai][1][m][0][e]); o1[e] = sigmoidf_(gs[4 + e]) * acc[ai][0][m][1][e] * sigmoidf_(acc[ai][1][m][1][e]); } \
      *(u32x4*)(MS + (size_t)(row0 + (ai) * 128 + m * 16) * 1024 + col) = pack8(o0, o1); } } while (0)
    GLU_LOAD(0, buf[0]); GLU_LOAD(1, buf[1]); GLU_DO(0, buf[0]); GLU_DO(1, buf[1]);
#undef GLU_LOAD
#undef GLU_DO
  }
};
struct EpiWo {
  static constexpr bool PERM = true, AFTER_DRAIN = false;
  const bf16_t* GL; const bf16_t* MS; bf16_t* MM;
  __device__ __forceinline__ void operator()(const f32x4 (&acc)[2][2][4][2], const Unit& u, int wr, int wc, int fr, int fq) const {
    const int col0 = u.pn * 256 + wc * 32 + 8 * fq, row0 = u.pm * 256 + wr * 64 + fr;
    u32x4 bg[2][4], bm[2][4];
#define WO_LOAD(ai, mh, dg, dm) do { _Pragma("unroll") for (int mm = 0; mm < 2; ++mm) _Pragma("unroll") for (int bj = 0; bj < 2; ++bj) { const size_t r = (size_t)(row0 + (ai) * 128 + ((mh) * 2 + mm) * 16); \
      dg[mm * 2 + bj] = *(const u32x4*)(GL + r * 2048 + col0 + bj * 128); dm[mm * 2 + bj] = *(const u32x4*)(MS + r * 1024 + col0 + bj * 128); } } while (0)
#define WO_DO(ai, mh, dg, dm) do { _Pragma("unroll") for (int mm = 0; mm < 2; ++mm) _Pragma("unroll") for (int bj = 0; bj < 2; ++bj) { const int m = (mh) * 2 + mm; float ga[8], ms[8]; unpack8(dg[mm * 2 + bj], ga); unpack8(dm[mm * 2 + bj], ms); f32x4 o0, o1; \
      _Pragma("unroll") for (int e = 0; e < 4; ++e) { o0[e] = sigmoidf_(ga[e]) * acc[ai][bj][m][0][e] + ms[e]; o1[e] = sigmoidf_(ga[4 + e]) * acc[ai][bj][m][1][e] + ms[4 + e]; } \
      *(u32x4*)(MM + (size_t)(row0 + (ai) * 128 + m * 16) * 1024 + col0 + bj * 128) = pack8(o0, o1); } } while (0)
    WO_LOAD(0, 0, bg[0], bm[0]); WO_LOAD(0, 1, bg[1], bm[1]); WO_DO(0, 0, bg[0], bm[0]);
    WO_LOAD(1, 0, bg[0], bm[0]); WO_DO(0, 1, bg[1], bm[1]);
    WO_LOAD(1, 1, bg[1], bm[1]); WO_DO(1, 0, bg[0], bm[0]); WO_DO(1, 1, bg[1], bm[1]);
#undef WO_LOAD
#undef WO_DO
  }
};
struct EpiRes {
  static constexpr bool PERM = true, AFTER_DRAIN = false;
  const float* base; const float* mod; int goff; float* out;
  __device__ __forceinline__ void operator()(const f32x4 (&acc)[2][2][4][2], const Unit& u, int wr, int wc, int fr, int fq) const {
    const int col0 = u.pn * 256 + wc * 32 + 8 * fq, row0 = u.pm * 256 + wr * 64 + fr, b = (u.pm * 256) / SEQ;
    f32x4 g[2][2];
#pragma unroll
    for (int bj = 0; bj < 2; ++bj)
#pragma unroll
      for (int n = 0; n < 2; ++n) g[bj][n] = *(const f32x4*)(mod + b * 6144 + goff + col0 + bj * 128 + 4 * n);
    f32x4 bb[2][8];
#define RES_LOAD(ai, mh, d) do { _Pragma("unroll") for (int mm = 0; mm < 2; ++mm) _Pragma("unroll") for (int bj = 0; bj < 2; ++bj) _Pragma("unroll") for (int n = 0; n < 2; ++n) \
      d[(mm * 2 + bj) * 2 + n] = *(const f32x4*)(base + (size_t)(row0 + (ai) * 128 + ((mh) * 2 + mm) * 16) * 1024 + col0 + bj * 128 + 4 * n); } while (0)
#define RES_DO(ai, mh, d) do { _Pragma("unroll") for (int mm = 0; mm < 2; ++mm) _Pragma("unroll") for (int bj = 0; bj < 2; ++bj) _Pragma("unroll") for (int n = 0; n < 2; ++n) \
      *(f32x4*)(out + (size_t)(row0 + (ai) * 128 + ((mh) * 2 + mm) * 16) * 1024 + col0 + bj * 128 + 4 * n) = d[(mm * 2 + bj) * 2 + n] + g[bj][n] * acc[ai][bj][(mh) * 2 + mm][n]; } while (0)
    RES_LOAD(0, 0, bb[0]); RES_LOAD(0, 1, bb[1]); RES_DO(0, 0, bb[0]);
    RES_LOAD(1, 0, bb[0]); RES_DO(0, 1, bb[1]);
    RES_LOAD(1, 1, bb[1]); RES_DO(1, 0, bb[0]); RES_DO(1, 1, bb[1]);
#undef RES_LOAD
#undef RES_DO
  }
};

template <int CTRL> __device__ __forceinline__ float dppf(float old, float src) {
  return __builtin_bit_cast(float, __builtin_amdgcn_update_dpp(__builtin_bit_cast(int, old), __builtin_bit_cast(int, src), CTRL, 0xf, 0xf, false));
}
struct EpiUp {
  static constexpr bool PERM = true, AFTER_DRAIN = false;
  const float* conv_w; const float* conv_b; bf16_t* ACT; float* ex;
  template <bool PREV, bool NEXT>
  static __device__ __forceinline__ void shift4(f32x4& o, const f32x4 a, const f32x4 c, const f32x4 ap, const f32x4 cn, float m0, float m15) {
    float o0 = o[0], o1 = o[1], o2 = o[2], o3 = o[3];
    asm volatile("s_nop 1\n\t"
      "v_add_f32_dpp %0, %4, %0 row_shr:1 row_mask:0xf bank_mask:0xf bound_ctrl:1\n\tv_add_f32_dpp %0, %8, %0 row_shl:1 row_mask:0xf bank_mask:0xf bound_ctrl:1\n\t"
      "v_add_f32_dpp %1, %5, %1 row_shr:1 row_mask:0xf bank_mask:0xf bound_ctrl:1\n\tv_add_f32_dpp %1, %9, %1 row_shl:1 row_mask:0xf bank_mask:0xf bound_ctrl:1\n\t"
      "v_add_f32_dpp %2, %6, %2 row_shr:1 row_mask:0xf bank_mask:0xf bound_ctrl:1\n\tv_add_f32_dpp %2, %10, %2 row_shl:1 row_mask:0xf bank_mask:0xf bound_ctrl:1\n\t"
      "v_add_f32_dpp %3, %7, %3 row_shr:1 row_mask:0xf bank_mask:0xf bound_ctrl:1\n\tv_add_f32_dpp %3, %11, %3 row_shl:1 row_mask:0xf bank_mask:0xf bound_ctrl:1"
      : "+v"(o0), "+v"(o1), "+v"(o2), "+v"(o3) : "v"(a[0]), "v"(a[1]), "v"(a[2]), "v"(a[3]), "v"(c[0]), "v"(c[1]), "v"(c[2]), "v"(c[3]));
    if constexpr (PREV) asm volatile("s_nop 1\n\t"
      "v_fmac_f32_dpp %0, %4, %8 row_ror:1 row_mask:0xf bank_mask:0xf\n\tv_fmac_f32_dpp %1, %5, %8 row_ror:1 row_mask:0xf bank_mask:0xf\n\t"
      "v_fmac_f32_dpp %2, %6, %8 row_ror:1 row_mask:0xf bank_mask:0xf\n\tv_fmac_f32_dpp %3, %7, %8 row_ror:1 row_mask:0xf bank_mask:0xf"
      : "+v"(o0), "+v"(o1), "+v"(o2), "+v"(o3) : "v"(ap[0]), "v"(ap[1]), "v"(ap[2]), "v"(ap[3]), "v"(m0));
    if constexpr (NEXT) asm volatile("s_nop 1\n\t"
      "v_fmac_f32_dpp %0, %4, %8 row_ror:15 row_mask:0xf bank_mask:0xf\n\tv_fmac_f32_dpp %1, %5, %8 row_ror:15 row_mask:0xf bank_mask:0xf\n\t"
      "v_fmac_f32_dpp %2, %6, %8 row_ror:15 row_mask:0xf bank_mask:0xf\n\tv_fmac_f32_dpp %3, %7, %8 row_ror:15 row_mask:0xf bank_mask:0xf"
      : "+v"(o0), "+v"(o1), "+v"(o2), "+v"(o3) : "v"(cn[0]), "v"(cn[1]), "v"(cn[2]), "v"(cn[3]), "v"(m15));
    o = (f32x4){o0, o1, o2, o3};
  }
  __device__ __forceinline__ void operator()(const f32x4 (&acc)[2][2][4][2], const Unit& u, int wr, int wc, int fr, int fq) const {
    const int b = u.pm / 33, ti = u.pm % 33, lc0 = wc * 32 + 8 * fq;
#pragma unroll
    for (int ai = 0; ai < 2; ++ai) { const int seg = 2 * ai + wr;
      if (fr == 0) {
#pragma unroll
        for (int bj = 0; bj < 2; ++bj)
#pragma unroll
          for (int n = 0; n < 2; ++n) *(f32x4*)(ex + ((seg * 2 + 0) * 2 + bj) * 128 + lc0 + 4 * n) = acc[ai][bj][0][n]; }
      if (fr == 15) {
#pragma unroll
        for (int bj = 0; bj < 2; ++bj)
#pragma unroll
          for (int n = 0; n < 2; ++n) *(f32x4*)(ex + ((seg * 2 + 1) * 2 + bj) * 128 + lc0 + 4 * n) = acc[ai][bj][3][n]; } }
    asm volatile("s_waitcnt lgkmcnt(0)" ::: "memory"); __builtin_amdgcn_s_barrier(); asm volatile("" ::: "memory");
    const float m0 = fr == 0 ? 1.f : 0.f, m15 = fr == 15 ? 1.f : 0.f;
    const bool zp = (ti == 0 && wr == 0 && fr == 0), zn = (ti == 32 && wr == 1 && fr == 1);
    u32x2 hold[2][4];
#pragma unroll
    for (int n = 0; n < 2; ++n) {
      const int col = u.pn * 128 + lc0 + 4 * n;
      f32x4 w0[2], w1[2], w2[2], bs[2];
#pragma unroll
      for (int bj = 0; bj < 2; ++bj) { w0[bj] = *(const f32x4*)(conv_w + bj * FH + col); w1[bj] = *(const f32x4*)(conv_w + 5632 + bj * FH + col); w2[bj] = *(const f32x4*)(conv_w + 2 * 5632 + bj * FH + col); bs[bj] = *(const f32x4*)(conv_b + bj * FH + col); }
#pragma unroll
      for (int ai = 0; ai < 2; ++ai) { const int seg = 2 * ai + wr;
        f32x4 ap[2], en[2];
#pragma unroll
        for (int bj = 0; bj < 2; ++bj) {
          const f32x4 pe = seg > 0 ? *(const f32x4*)(ex + (((seg - 1) * 2 + 1) * 2 + bj) * 128 + lc0 + 4 * n) : (f32x4){0.f, 0.f, 0.f, 0.f};
          const f32x4 ne = seg < 3 ? *(const f32x4*)(ex + (((seg + 1) * 2 + 0) * 2 + bj) * 128 + lc0 + 4 * n) : (f32x4){0.f, 0.f, 0.f, 0.f};
          ap[bj] = w0[bj] * pe; en[bj] = w2[bj] * ne; }
#pragma unroll
        for (int m = 0; m < 4; ++m) {
          f32x4 vg[2];
#pragma unroll
          for (int bj = 0; bj < 2; ++bj) {
            const f32x4 x = acc[ai][bj][m][n];
            f32x4 a = w0[bj] * x, c = w2[bj] * x, o = w1[bj] * x + bs[bj];
            if (ai == 0 && m == 0) { if (zp) a = (f32x4){0.f, 0.f, 0.f, 0.f}; if (zn) c = (f32x4){0.f, 0.f, 0.f, 0.f}; }
            if (m == 0) { o += ap[bj] * m0; const f32x4 cn = w2[bj] * acc[ai][bj][1][n]; shift4<false, true>(o, a, c, a, cn, m0, m15); }
            else if (m == 3) { o += en[bj] * m15; shift4<true, false>(o, a, c, ap[bj], c, m0, m15); }
            else { const f32x4 cn = w2[bj] * acc[ai][bj][m == 3 ? 3 : m + 1][n]; shift4<true, true>(o, a, c, ap[bj], cn, m0, m15); }
            ap[bj] = a; vg[bj] = o; }
          const int lr = ai * 128 + wr * 64 + m * 16 + fr, t = 254 * ti - 1 + lr;
          { const f32x4 val = vg[0], gate = vg[1];
            u32x2 w; w.x = pk2(gate[0] * sigmoidf_(gate[0]) * val[0], gate[1] * sigmoidf_(gate[1]) * val[1]); w.y = pk2(gate[2] * sigmoidf_(gate[2]) * val[2], gate[3] * sigmoidf_(gate[3]) * val[3]);
            if (n == 0) hold[ai][m] = w;
            else if (lr >= 1 && lr <= 254 && t < SEQ) { u32x4 w4; w4.x = hold[ai][m].x; w4.y = hold[ai][m].y; w4.z = w.x; w4.w = w.y; *(u32x4*)(ACT + ((size_t)(b * SEQ + t)) * FH + col - 4) = w4; } } }
      }
    }
  }
};
struct UpOrder {
  pg8::TileOrder T; const char* A;
  __device__ bool next(int i, Unit& u) const {
    if (!T.next(i, u)) return false;
    const int b = u.pm / 33, ti = u.pm % 33; u.a = A + ((long)(b * SEQ + 254 * ti - 1)) * 2048; return true;
  }
};


struct EpiS {
  static constexpr bool PERM = true, AFTER_DRAIN = false;
  float* S;
  __device__ __forceinline__ void operator()(const f32x4 (&acc)[2][2][4][2], const Unit& u, int wr, int wc, int fr, int fq) const {
#pragma unroll
    for (int ai = 0; ai < 2; ++ai)
#pragma unroll
      for (int m = 0; m < 4; ++m) { const int row = u.pm * 256 + ai * 128 + wr * 64 + m * 16 + fr; float* o = S + ((size_t)u.pn * UA_ROWS + row) * 256 + wc * 32 + 8 * fq;
#pragma unroll
        for (int bj = 0; bj < 2; ++bj)
#pragma unroll
          for (int n = 0; n < 2; ++n) *(f32x4*)(o + bj * 128 + 4 * n) = acc[ai][bj][m][n]; }
  }
};
struct EpiY {
  static constexpr bool PERM = true, AFTER_DRAIN = false;
  bf16_t* GY;
  __device__ __forceinline__ void operator()(const f32x4 (&acc)[2][2][4][2], const Unit& u, int wr, int wc, int fr, int fq) const {
    const int g = u.pn >> 1, pn = u.pn & 1;
#pragma unroll
    for (int ai = 0; ai < 2; ++ai)
#pragma unroll
      for (int m = 0; m < 4; ++m) { const int row = u.pm * 256 + ai * 128 + wr * 64 + m * 16 + fr, b = row >> 8, c = row & 255;
#pragma unroll
        for (int bj = 0; bj < 2; ++bj) { const int col = pn * 256 + bj * 128 + wc * 32 + 8 * fq, i = col >> 4, p0 = col & 15;
          f32x4 o0, o1;
#pragma unroll
          for (int e = 0; e < 4; ++e) { o0[e] = gelu_tanh(acc[ai][bj][m][0][e]); o1[e] = gelu_tanh(acc[ai][bj][m][1][e]); }
          *(u32x4*)(GY + ((size_t)(b * SEQ + c * CL + i)) * SW + g * 16 + p0) = pack8(o0, o1); } }
  }
};
struct CtxOrder {
  int G, c; const char* A; const char* B;
  __device__ bool next(int i, Unit& u) const { const int first = (G >= NG * 5 + 16) ? NG * 5 : 0; const int L = i * G + c - first; if (L < 0 || L >= 16) return false;
    u.pm = NTOK / 256 + L / 4; u.pn = L % 4; u.a = A + (size_t)u.pm * 256 * KVL * 2; u.b = B + (size_t)u.pn * 256 * KVL * 2; return true; }
};
struct SOrder {
  int G, c; const char* A; const char* B;
  __device__ bool next(int i, Unit& u) const { const int L = i * G + c; if (L >= NG * 5) return false; const int g = L / 5; u.pm = L % 5; u.pn = g;
    u.a = A + ((size_t)g * UA_ROWS + u.pm * 256) * UA_K * 2; u.b = B + (size_t)g * 256 * 512 * 2; return true; }
};
struct YOrder {
  int G, c; const char* A; const char* B;
  __device__ bool next(int i, Unit& u) const { const int L = i * G + c; if (L >= NG * 8) return false; const int g = L >> 3; u.pm = (L & 7) >> 1; u.pn = g * 2 + (L & 1);
    u.a = A + ((size_t)g * UA_ROWS + u.pm * 256) * UA_K * 2; u.b = B + ((size_t)g * 512 + (L & 1) * 256) * UA_K * 2; return true; }
};


struct EpiQ {
  static constexpr bool PERM = true, AFTER_DRAIN = false;
  const float* RSQ; const float* qng; const float* rope; bf16_t* Q; float* ex;
  __device__ __forceinline__ void operator()(const f32x4 (&acc)[2][2][4][2], const Unit& u, int wr_, int wc_, int fr_, int fq_) const {
    int fr = fr_, fq = fq_, wr = wr_, wc = wc_; asm volatile("" : "+v"(fr), "+v"(fq), "+s"(wr), "+s"(wc));
    float rsqv[2][4];
#pragma unroll
    for (int ai = 0; ai < 2; ++ai)
#pragma unroll
      for (int m = 0; m < 4; ++m) rsqv[ai][m] = RSQ[u.pm * 256 + ai * 128 + wr * 64 + m * 16 + fr];
#pragma unroll
    for (int ai = 0; ai < 2; ++ai)
#pragma unroll
      for (int m = 0; m < 4; ++m) { const int lr = ai * 128 + wr * 64 + m * 16 + fr;
#pragma unroll
        for (int bj = 0; bj < 2; ++bj) { const int bc = bj * 4 + wc; const f32x4 a0 = acc[ai][bj][m][0], a1 = acc[ai][bj][m][1];
          float ss = (a0[0] * a0[0] + a0[1] * a0[1]) + (a0[2] * a0[2] + a0[3] * a0[3]) + (a1[0] * a1[0] + a1[1] * a1[1]) + (a1[2] * a1[2] + a1[3] * a1[3]);
          ss = fq_sum(ss);
          if (fq == 0) ex[lr * 8 + bc] = ss; }
        asm volatile("" ::: "memory"); }
    asm volatile("s_waitcnt lgkmcnt(0)" ::: "memory"); __builtin_amdgcn_s_barrier(); asm volatile("" ::: "memory");
    const bool needr = (wc == 1 || wc == 2);
    f32x4 gq[2][2];
#pragma unroll
    for (int bj = 0; bj < 2; ++bj)
#pragma unroll
      for (int n = 0; n < 2; ++n) { const int bc = bj * 4 + wc; gq[bj][n] = bc < 6 ? *(const f32x4*)(qng + (bc % 3) * 32 + 8 * fq + 4 * n) : (f32x4){0.f, 0.f, 0.f, 0.f}; }
    f32x4 rp[2][4];
#define Q_RLOAD(k, d) do { const int t_ = (u.pm * 256 + ((k) >> 2) * 128 + wr * 64 + ((k) & 3) * 16 + fr) % SEQ; const float* rb_ = rope + (t_ * 16 + 8 * (fq & 1)) * 2; \
      d[0] = *(const f32x4*)(rb_); d[1] = *(const f32x4*)(rb_ + 4); d[2] = *(const f32x4*)(rb_ + 8); d[3] = *(const f32x4*)(rb_ + 12); } while (0)
    if (needr) Q_RLOAD(0, rp[0]);
#pragma unroll
    for (int k = 0; k < 8; ++k) { const int ai = k >> 2, m = k & 3;
      if (needr && k + 1 < 8) Q_RLOAD(k + 1, rp[(k + 1) & 1]);
      const int lr = ai * 128 + wr * 64 + m * 16 + fr, row = u.pm * 256 + lr, b = row / SEQ, t = row % SEQ;
      const float rsq = rsqrtf(rsqv[ai][m] * (1.f / QL) + EPS);
#pragma unroll
      for (int bj = 0; bj < 2; ++bj) { const int bc = bj * 4 + wc;
        if (bc < 6) { const int hh = bc / 3, third = bc % 3, h = u.pn * 2 + hh;
          const float tot = rsq * rsq * (ex[lr * 8 + 3 * hh] + ex[lr * 8 + 3 * hh + 1] + ex[lr * 8 + 3 * hh + 2]);
          const float sc = rsq * rsqrtf(tot * (1.f / QKD) + EPS) * QSCALE;
#pragma unroll
          for (int n = 0; n < 2; ++n) { const int d0 = third * 32 + 8 * fq + 4 * n; float v[4];
#pragma unroll
            for (int e = 0; e < 4; ++e) v[e] = acc[ai][bj][m][n][e] * sc * gq[bj][n][e];
            if (third == 2) { const f32x4 r0 = rp[k & 1][2 * n], r1 = rp[k & 1][2 * n + 1];
              const float cs[4] = {r0[0], r0[2], r1[0], r1[2]}, sn[4] = {r0[1], r0[3], r1[1], r1[3]};
#pragma unroll
              for (int e = 0; e < 4; ++e) { const float other = xor32(v[e], fq < 2);
                v[e] = fq < 2 ? v[e] * cs[e] - other * sn[e] : other * sn[e] + v[e] * cs[e]; } }
            u32x2 w; w.x = pk2(v[0], v[1]); w.y = pk2(v[2], v[3]);
            *(u32x2*)(Q + ((size_t)(b * NH + h) * SEQ + t) * QKD + d0) = w; } } } }
#undef Q_RLOAD
  }
};
struct EpiKV {
  static constexpr bool PERM = true, AFTER_DRAIN = false;
  const float* RSK; const float* RSR; const bf16_t* KR; const float* kng; const float* rope; bf16_t* Kb; bf16_t* Vb; float* ex;
  __device__ __forceinline__ void operator()(const f32x4 (&acc)[2][2][4][2], const Unit& u, int wr_, int wc_, int fr_, int fq_) const {
    int fr = fr_, fq = fq_, wr = wr_, wc = wc_; asm volatile("" : "+v"(fr), "+v"(fq), "+s"(wr), "+s"(wc));
    float rskv[2][4], rsrv[2][4];
#pragma unroll
    for (int ai = 0; ai < 2; ++ai)
#pragma unroll
      for (int m = 0; m < 4; ++m) { const int row = u.pm * 256 + ai * 128 + wr * 64 + m * 16 + fr; rskv[ai][m] = RSK[row]; rsrv[ai][m] = RSR[row]; }
    if (wc < 2) {
#pragma unroll
      for (int ai = 0; ai < 2; ++ai)
#pragma unroll
        for (int m = 0; m < 4; ++m) { const int lr = ai * 128 + wr * 64 + m * 16 + fr;
#pragma unroll
          for (int bj = 0; bj < 2; ++bj) { const f32x4 a0 = acc[ai][bj][m][0], a1 = acc[ai][bj][m][1];
            float ss = (a0[0] * a0[0] + a0[1] * a0[1]) + (a0[2] * a0[2] + a0[3] * a0[3]) + (a1[0] * a1[0] + a1[1] * a1[1]) + (a1[2] * a1[2] + a1[3] * a1[3]);
            ss = fq_sum(ss);
            if (fq == 0) ex[lr * 4 + bj * 2 + wc] = ss; }
          asm volatile("" ::: "memory"); }
    }
    asm volatile("s_waitcnt lgkmcnt(0)" ::: "memory"); __builtin_amdgcn_s_barrier(); asm volatile("" ::: "memory");
    const bool latent = u.pm * 256 < NTOK, kr_wave = (wc == 2);
    const f32x4 g0 = *(const f32x4*)(kng + (wc & 1) * 32 + 8 * fq), g1 = *(const f32x4*)(kng + (wc & 1) * 32 + 8 * fq + 4);
    const f32x4 gk0 = *(const f32x4*)(kng + 64 + 8 * fq), gk1 = *(const f32x4*)(kng + 64 + 8 * fq + 4);
    f32x4 rp[4]; u32x2 kw[2];
#define KV_RLOAD(k) do { const int row_ = u.pm * 256 + ((k) >> 2) * 128 + wr * 64 + ((k) & 3) * 16 + fr; kw[0] = *(const u32x2*)(KR + (size_t)row_ * 32 + 8 * fq); kw[1] = *(const u32x2*)(KR + (size_t)row_ * 32 + 8 * fq + 4); \
      if (latent) { const float* rb_ = rope + ((row_ % SEQ) * 16 + 8 * (fq & 1)) * 2; rp[0] = *(const f32x4*)(rb_); rp[1] = *(const f32x4*)(rb_ + 4); rp[2] = *(const f32x4*)(rb_ + 8); rp[3] = *(const f32x4*)(rb_ + 12); } } while (0)
    if (kr_wave) KV_RLOAD(0);
#pragma unroll
    for (int k = 0; k < 8; ++k) { const int ai = k >> 2, m = k & 3;
      float base[2][4];
      if (kr_wave) {
#pragma unroll
        for (int n = 0; n < 2; ++n) { const u32x2 w_ = kw[n]; float v[4] = {lo16(w_.x), hi16(w_.x), lo16(w_.y), hi16(w_.y)}; const f32x4 gk = n ? gk1 : gk0;
#pragma unroll
          for (int e = 0; e < 4; ++e) v[e] *= gk[e];
          if (latent) { const f32x4 r0 = rp[2 * n], r1 = rp[2 * n + 1];
            const float cs[4] = {r0[0], r0[2], r1[0], r1[2]}, sn[4] = {r0[1], r0[3], r1[1], r1[3]};
#pragma unroll
            for (int e = 0; e < 4; ++e) { const float other = xor32(v[e], fq < 2);
              v[e] = fq < 2 ? v[e] * cs[e] - other * sn[e] : other * sn[e] + v[e] * cs[e]; } }
#pragma unroll
          for (int e = 0; e < 4; ++e) base[n][e] = v[e]; }
        if (k + 1 < 8) KV_RLOAD(k + 1);
      }
      const int lr = ai * 128 + wr * 64 + m * 16 + fr, row = u.pm * 256 + lr;
      int b, key;
      if (latent) { b = row / SEQ; key = row % SEQ; } else { const int mc = row - NTOK; b = mc / CTX; key = SEQ + mc % CTX; }
      const float rsk = rsqrtf(rskv[ai][m] * (1.f / KVL) + EPS), rsr = rsrv[ai][m];
#pragma unroll
      for (int bj = 0; bj < 2; ++bj) { const int h = u.pn * 2 + bj; const size_t kvrow = (size_t)(b * NH + h) * SKV + key;
        const float r2 = rsqrtf((rsk * rsk * (ex[lr * 4 + bj * 2] + ex[lr * 4 + bj * 2 + 1]) + rsr) * (1.f / QKD) + EPS);
        if (wc < 2) { const int d0 = wc * 32 + 8 * fq; f32x4 o0, o1;
#pragma unroll
          for (int e = 0; e < 4; ++e) { o0[e] = acc[ai][bj][m][0][e] * rsk * r2 * g0[e]; o1[e] = acc[ai][bj][m][1][e] * rsk * r2 * g1[e]; }
          *(u32x4*)(Kb + kvrow * KP + d0) = pack8(o0, o1); }
        else { const int d0 = (wc - 2) * 32 + 8 * fq;
          *(u32x4*)(Vb + kvrow * VD + d0) = pack8(acc[ai][bj][m][0] * rsk, acc[ai][bj][m][1] * rsk);
          if (kr_wave) { u32x4 w; w.x = pk2(base[0][0] * r2, base[0][1] * r2); w.y = pk2(base[0][2] * r2, base[0][3] * r2); w.z = pk2(base[1][0] * r2, base[1][1] * r2); w.w = pk2(base[1][2] * r2, base[1][3] * r2);
            *(u32x4*)(Kb + kvrow * KP + 64 + 8 * fq) = w; } } } }
#undef KV_RLOAD
  }
};

struct InOrder {
  pg8::TileOrder T; int G, c; const char* A; const char* B;
  __device__ bool next(int i, Unit& u) const {
    if (T.next(i, u)) return true;
    const long L = (long)i * G + c - T.nwg; if (L < 0 || L >= 16) return false;
    u.pm = 128 + (int)L / 4; u.pn = 1 + (int)L % 4; u.a = A + (size_t)u.pm * T.tsA; u.b = B + (size_t)u.pn * T.tsB; return true;
  }
};

namespace att {
using f32x16 = __attribute__((ext_vector_type(16))) float;
using s16x4 = __attribute__((ext_vector_type(4))) short;
constexpr int QBLK = 32, KVBLK = 64, NW = 8;
constexpr float SCALE = 0.10206207261596577f;
constexpr float THR = 8.f;
constexpr int SHM_V = KVBLK * 64 * 2, SHM_K = KVBLK * 128 * 2, SHM_ATTN = 2 * SHM_V + 2 * SHM_K + NW * 64 * 4;
#define KSWZ(row, colB) ((row) * 256 + ((colB) ^ (((row) & 7) << 4)))
#define SBAR() __builtin_amdgcn_sched_barrier(0)
__device__ __forceinline__ int crow(int r, int hi) { return (r & 3) + 8 * (r >> 2) + 4 * hi; }
template <bool FAST>
__device__ __forceinline__ void partialSM(f32x16& p0, f32x16& p1, float& m_reg, float& mn, float& alpha) {
  if constexpr (!FAST) {
    constexpr float THR2 = THR * 1.4426950408889634f;
    float pmax = p0[0];
#pragma unroll
    for (int r = 1; r < 16; ++r) pmax = fmaxf(pmax, p0[r]);
#pragma unroll
    for (int r = 0; r < 16; ++r) pmax = fmaxf(pmax, p1[r]);
    { auto rr = __builtin_amdgcn_permlane32_swap(__float_as_uint(pmax), __float_as_uint(pmax), false, false);
      pmax = fmaxf(__uint_as_float(rr[0]), __uint_as_float(rr[1])); }
    if (__builtin_expect(__all(pmax - m_reg <= THR2), 1)) { mn = m_reg; alpha = 1.f; }
    else { mn = fmaxf(m_reg, pmax); alpha = __builtin_amdgcn_exp2f(m_reg - mn); m_reg = mn; }
#pragma unroll
    for (int r = 0; r < 16; ++r) p0[r] -= mn;
#pragma unroll
    for (int r = 0; r < 16; ++r) p1[r] -= mn;
  } else { alpha = 1.f; }
#pragma unroll
  for (int r = 0; r < 16; ++r) p0[r] = __builtin_amdgcn_exp2f(p0[r]);
}
__device__ __forceinline__ void finishSM(f32x16& p0, f32x16& p1, float alpha, float& l_reg, bf16x8& pa0, bf16x8& pa1, bf16x8& pa2, bf16x8& pa3) {
#pragma unroll
  for (int r = 0; r < 16; ++r) p1[r] = __builtin_amdgcn_exp2f(p1[r]);
  float ps = 0;
#pragma unroll
  for (int r = 0; r < 16; ++r) ps += p0[r];
#pragma unroll
  for (int r = 0; r < 16; ++r) ps += p1[r];
  { auto rr = __builtin_amdgcn_permlane32_swap(__float_as_uint(ps), __float_as_uint(ps), false, false);
    ps = __uint_as_float(rr[0]) + __uint_as_float(rr[1]); }
  l_reg = l_reg * alpha + ps;
#define PK4(P, BASE, OUT) do { unsigned a0 = pk2(P[BASE + 0], P[BASE + 1]), a1 = pk2(P[BASE + 2], P[BASE + 3]);   \
    unsigned b0 = pk2(P[BASE + 4], P[BASE + 5]), b1 = pk2(P[BASE + 6], P[BASE + 7]);                              \
    auto r0 = __builtin_amdgcn_permlane32_swap(a0, b0, false, false); auto r1 = __builtin_amdgcn_permlane32_swap(a1, b1, false, false); \
    u32x4 w = {r0[0], r1[0], r0[1], r1[1]}; OUT = *reinterpret_cast<bf16x8*>(&w); } while (0)
  PK4(p0, 0, pa0); PK4(p0, 8, pa1); PK4(p1, 0, pa2); PK4(p1, 8, pa3);
#undef PK4
}
__device__ __forceinline__ void qkt(f32x16& p0, f32x16& p1, const char* Ks, const bf16x8* qr, int r32, int hi) {
  p0 = f32x16{}; p1 = f32x16{};
#pragma unroll
  for (int d0 = 0; d0 < 6; ++d0) { const int cb = (d0 * 16 + hi * 8) * 2;
    const bf16x8 b0 = *reinterpret_cast<const bf16x8*>(Ks + KSWZ(r32, cb));
    const bf16x8 b1 = *reinterpret_cast<const bf16x8*>(Ks + KSWZ(32 + r32, cb));
    p0 = __builtin_amdgcn_mfma_f32_32x32x16_bf16(b0, qr[d0], p0, 0, 0, 0);
    p1 = __builtin_amdgcn_mfma_f32_32x32x16_bf16(b1, qr[d0], p1, 0, 0, 0); }
}
__device__ __forceinline__ int v_st(int k, int c) { const int kk = (k & ~0xC) | ((k & 4) << 1) | ((k & 8) >> 1); return ((kk >> 3) * 2 + (c >> 5)) * 512 + ((kk & 7) * 32 + (c & 31)) * 2; }
__device__ __forceinline__ int v_rd_base(int lane) { return ((lane & 3) << 3) | (((lane >> 2) & 3) << 6) | (((lane >> 4) & 1) << 5) | (((lane >> 5) & 1) << 8); }
constexpr int v_rd_off(int d0, int ks, int half) { return d0 * 512 + ks * 2048 + half * 1024; }
template <int OFF> __device__ __forceinline__ s16x4 tr_read(int vb) {
  s16x4 r; asm volatile("ds_read_b64_tr_b16 %0, %1 offset:%2" : "=&v"(r) : "v"(vb), "i"(OFF) : "memory"); return r;
}
template <int D0> __device__ __forceinline__ void pv_one(f32x16& od, int vb, bf16x8 pa0, bf16x8 pa1, bf16x8 pa2, bf16x8 pa3) {
  const s16x4 l0 = tr_read<v_rd_off(D0, 0, 0)>(vb), h0 = tr_read<v_rd_off(D0, 0, 1)>(vb), l1 = tr_read<v_rd_off(D0, 1, 0)>(vb), h1 = tr_read<v_rd_off(D0, 1, 1)>(vb);
  const s16x4 l2 = tr_read<v_rd_off(D0, 2, 0)>(vb), h2 = tr_read<v_rd_off(D0, 2, 1)>(vb), l3 = tr_read<v_rd_off(D0, 3, 0)>(vb), h3 = tr_read<v_rd_off(D0, 3, 1)>(vb);
  asm volatile("s_waitcnt lgkmcnt(0)" ::: "memory"); SBAR();
#define PK(L, H) (bf16x8){L[0], L[1], L[2], L[3], H[0], H[1], H[2], H[3]}
  od = __builtin_amdgcn_mfma_f32_32x32x16_bf16(pa0, PK(l0, h0), od, 0, 0, 0);
  od = __builtin_amdgcn_mfma_f32_32x32x16_bf16(pa1, PK(l1, h1), od, 0, 0, 0);
  od = __builtin_amdgcn_mfma_f32_32x32x16_bf16(pa2, PK(l2, h2), od, 0, 0, 0);
  od = __builtin_amdgcn_mfma_f32_32x32x16_bf16(pa3, PK(l3, h3), od, 0, 0, 0);
#undef PK
}
__device__ __forceinline__ void pv_d0(f32x16* o, int vb, bf16x8 pa0, bf16x8 pa1, bf16x8 pa2, bf16x8 pa3) {
  pv_one<0>(o[0], vb, pa0, pa1, pa2, pa3); pv_one<1>(o[1], vb, pa0, pa1, pa2, pa3);
}
template <bool FAST>
__device__ __forceinline__ void attn_unit(const bf16_t* __restrict__ Qb, const bf16_t* __restrict__ Kh, const bf16_t* __restrict__ Vh, bf16_t* __restrict__ Ob, int seq, char* lds) {
  const int tid = threadIdx.x, wid = tid >> 6, lane = tid & 63, r32 = lane & 31, hi = lane >> 5;
  char* V_lds = lds; char* K_lds = lds + 2 * SHM_V;
  float* wsf = (float*)(lds + 2 * SHM_V + 2 * SHM_K) + wid * 64; float* li_l = wsf; float* al_l = wsf + 32;
  float m_reg = FAST ? 0.f : -1e30f, l_reg = 0; f32x16 o[2] = {}; bf16x8 qr[6];
  const bf16_t* Qw = Qb + (long)(wid * QBLK + r32) * QKD + hi * 8;
#pragma unroll
  for (int d0 = 0; d0 < 6; ++d0) qr[d0] = *reinterpret_cast<const bf16x8*>(Qw + d0 * 16);
  const int sr = tid >> 4, sc = (tid & 15) * 8;
  const int vk = tid >> 3, vc = (tid & 7) * 8, vst = v_st(vk, vc);
  const int vb0 = (int)(uintptr_t)V_lds + v_rd_base(lane);
  struct { bf16x8 vs, ks0, ks1; } sr_[2];
#define SLOAD(i, k0) do { sr_[i].vs = *reinterpret_cast<const bf16x8*>(&Vh[(long)((k0) + vk) * VD + vc]); \
    sr_[i].ks0 = *reinterpret_cast<const bf16x8*>(&Kh[(long)((k0) + sr) * KP + sc]); sr_[i].ks1 = *reinterpret_cast<const bf16x8*>(&Kh[(long)((k0) + 32 + sr) * KP + sc]); } while (0)
#define SWRITE(b, i) do { *(bf16x8*)(V_lds + (b) * SHM_V + vst) = sr_[i].vs; const int kc = sc * 2;               \
    *(bf16x8*)(K_lds + (b) * SHM_K + KSWZ(sr, kc)) = sr_[i].ks0;                       \
    *(bf16x8*)(K_lds + (b) * SHM_K + KSWZ(32 + sr, kc)) = sr_[i].ks1; } while (0)
#define SWAIT() asm volatile("s_waitcnt vmcnt(3)" ::: "memory")
#define RESC(a) do { if (!FAST && __any((a) < 1.f)) { if (hi == 0) al_l[r32] = (a); asm volatile("s_waitcnt lgkmcnt(0)" ::: "memory"); \
    _Pragma("unroll") for (int d = 0; d < 2; ++d) _Pragma("unroll") for (int r = 0; r < 16; ++r) o[d][r] *= al_l[crow(r, hi)]; } } while (0)
  f32x16 pA0, pA1, pB0, pB1; float mnA, mnB, alA, alB; bf16x8 pa0, pa1, pa2, pa3; const int NT = seq / KVBLK;
  constexpr int SE = 0, SO = 1;
  SLOAD(SE, 0); asm volatile("s_waitcnt vmcnt(0)" ::: "memory"); SWRITE(0, SE); __syncthreads();
  qkt(pA0, pA1, K_lds, qr, r32, hi); partialSM<FAST>(pA0, pA1, m_reg, mnA, alA);
  SLOAD(SO, KVBLK); if (2 < NT) SLOAD(SE, 2 * KVBLK);
  SWAIT(); SWRITE(1, SO); __syncthreads();
  for (int j = 1; j + 1 < NT; j += 2) {
    SBAR(); qkt(pB0, pB1, K_lds + SHM_K, qr, r32, hi);
    finishSM(pA0, pA1, alA, l_reg, pa0, pa1, pa2, pa3); SBAR();
    SLOAD(SO, (j + 2) * KVBLK); SBAR();
    pv_d0(o, vb0, pa0, pa1, pa2, pa3); partialSM<FAST>(pB0, pB1, m_reg, mnB, alB);
    __syncthreads(); SWAIT(); SWRITE(0, SE);
    RESC(alB); __syncthreads();
    SBAR(); qkt(pA0, pA1, K_lds, qr, r32, hi);
    finishSM(pB0, pB1, alB, l_reg, pa0, pa1, pa2, pa3); SBAR();
    if (j + 3 < NT) SLOAD(SE, (j + 3) * KVBLK); SBAR();
    pv_d0(o, vb0 + SHM_V, pa0, pa1, pa2, pa3); partialSM<FAST>(pA0, pA1, m_reg, mnA, alA);
    __syncthreads(); SWAIT(); SWRITE(1, SO);
    RESC(alA); __syncthreads();
  }
  SBAR(); qkt(pB0, pB1, K_lds + SHM_K, qr, r32, hi);
  finishSM(pA0, pA1, alA, l_reg, pa0, pa1, pa2, pa3); SBAR();
  pv_d0(o, vb0, pa0, pa1, pa2, pa3); partialSM<FAST>(pB0, pB1, m_reg, mnB, alB);
  __syncthreads(); RESC(alB);
  finishSM(pB0, pB1, alB, l_reg, pa0, pa1, pa2, pa3); SBAR();
  pv_d0(o, vb0 + SHM_V, pa0, pa1, pa2, pa3);
  if (hi == 0) li_l[r32] = l_reg; asm volatile("s_waitcnt lgkmcnt(0)" ::: "memory");
  bf16_t* Ow = Ob + (long)(wid * QBLK) * AW;
  {
    bf16_t* stg = (bf16_t*)(lds + 53248) + wid * 2048;
#pragma unroll
    for (int r = 0; r < 16; ++r) { const int orow = crow(r, hi); const float rl = __builtin_amdgcn_rcpf(li_l[orow]);
#pragma unroll
      for (int d0 = 0; d0 < 2; ++d0) stg[orow * 64 + d0 * 32 + r32] = f2bf(o[d0][r] * rl); }
    asm volatile("s_waitcnt lgkmcnt(0)" ::: "memory");
#pragma unroll 1
    for (int i = 0; i < 4; ++i) { const int row = i * 8 + (lane >> 3), ch = lane & 7; const u32x4 v = *(const u32x4*)(stg + row * 64 + ch * 8); *(u32x4*)(Ow + (long)row * AW + ch * 8) = v; } }
  __syncthreads();
#undef SLOAD
#undef SWRITE
#undef SWAIT
#undef RESC
}
#undef KSWZ
#undef SBAR
}

struct Params { const float* in[35]; float* out; char* ws; int ph_lo, ph_hi; };
enum { I_X = 0, I_C, I_CTX, I_CCTX, I_WMOD, I_BMOD, I_N1G, I_N2G, I_WIN, I_QAG, I_WUQ, I_KVAG, I_WUKV, I_QNG, I_KNG, I_WOA,
       I_LRF, I_LIF, I_LDTF, I_CRF, I_CIF, I_LRB, I_LIB, I_LDTB, I_CRB, I_CIB, I_BRE, I_BIM, I_DSKIP, I_WGLU, I_WOUT, I_WUP, I_CONVW, I_CONVB, I_WDN };
constexpr int LDS_BYTES = 147456;

__device__ __forceinline__ void tr_item(const float* W, int ldw, int k0, int n0, bf16_t* WT, int ldt, int drow0, const float* kscale, float* scr, int lane) {
#pragma unroll 8
  for (int i = 0; i < 32; ++i) { const int kk = 2 * i + (lane >> 5); float v = W[(size_t)(k0 + kk) * ldw + n0 + (lane & 31)]; if (kscale) v *= kscale[k0 + kk]; scr[kk * 33 + (lane & 31)] = v; }
  asm volatile("s_waitcnt lgkmcnt(0)" ::: "memory");
  const int c = lane & 7;
#pragma unroll
  for (int j = 0; j < 4; ++j) { const int n = (lane >> 3) + 8 * j; const float* s = scr + (8 * c) * 33 + n;
    u32x4 o; o.x = pk2(s[0 * 33], s[1 * 33]); o.y = pk2(s[2 * 33], s[3 * 33]); o.z = pk2(s[4 * 33], s[5 * 33]); o.w = pk2(s[6 * 33], s[7 * 33]);
    *(u32x4*)(WT + (size_t)(drow0 + n) * ldt + k0 + 8 * c) = o; }
  asm volatile("s_waitcnt lgkmcnt(0)" ::: "memory");
}
__device__ __forceinline__ int glu_row(int n0, int half) { return n0 < half ? (n0 / 128) * 256 + (n0 % 128) : ((n0 - half) / 128) * 256 + 128 + ((n0 - half) % 128); }


__device__ __forceinline__ void ssm_tables(const Params& p, unsigned char* lds, int g, int half) {
  const int tid = threadIdx.x;
  constexpr int PWP = 36;
  float* PWr = (float*)lds; float* PWi = PWr + 2 * 64 * PWP; float* CCr = PWi + 2 * 64 * PWP; float* CCi = CCr + 2 * 16 * 64;
  float* BBr = CCi + 2 * 16 * 64; float* BBi = BBr + 2 * 64 * 16; float* TK = BBi + 2 * 64 * 16;
  for (int idx = tid; idx < 2 * 33 * 64; idx += 512) { const int dir = idx / (33 * 64), k = (idx / 64) % 33, n = idx % 64;
    const float lr = p.in[dir ? I_LRB : I_LRF][g * SN + n], li = p.in[dir ? I_LIB : I_LIF][g * SN + n], dt = expf(p.in[dir ? I_LDTB : I_LDTF][g]);
    const float er = expf((float)k * lr * dt); const float sn = sinf((float)k * li * dt), cs = cosf((float)k * li * dt); PWr[(dir * 64 + n) * PWP + k] = er * cs; PWi[(dir * 64 + n) * PWP + k] = er * sn; }
  for (int idx = tid; idx < 2 * 16 * 64; idx += 512) { const int dir = idx / (16 * 64), pn = idx % (16 * 64);
    CCr[idx] = p.in[dir ? I_CRB : I_CRF][g * 16 * 64 + pn]; CCi[idx] = p.in[dir ? I_CIB : I_CIF][g * 16 * 64 + pn]; }
  for (int idx = tid; idx < 2 * 64 * 16; idx += 512) { const int dir = idx / (64 * 16), n = (idx / 16) % 64, j = idx % 16;
    const float lr = p.in[dir ? I_LRB : I_LRF][g * SN + n], li = p.in[dir ? I_LIB : I_LIF][g * SN + n], dt = expf(p.in[dir ? I_LDTB : I_LDTF][g]);
    const float er = expf(lr * dt); const float sn = sinf(li * dt), cs = cosf(li * dt); const float ar = er * cs, ai = er * sn;
    const float den = lr * lr + li * li, nr = ar - 1.f, ni = ai; const float cr = (nr * lr + ni * li) / den, ci = (ni * lr - nr * li) / den;
    const float br = p.in[I_BRE][(g * SN + n) * 16 + j], bi = p.in[I_BIM][(g * SN + n) * 16 + j]; BBr[idx] = cr * br - ci * bi; BBi[idx] = cr * bi + ci * br; }
  __syncthreads();
  { const int dir = tid >> 8, pp = (tid >> 4) & 15, j = tid & 15;
    const float* cr = CCr + (dir * 16 + pp) * 64; const float* ci = CCi + (dir * 16 + pp) * 64; const float* br = BBr + dir * 1024 + j; const float* bi = BBi + dir * 1024 + j;
    f32x4 tk[8];
#pragma unroll
    for (int k = 0; k < 8; ++k) tk[k] = (f32x4){0.f, 0.f, 0.f, 0.f};
    for (int n = 0; n < 64; ++n) { const float zr = cr[n] * br[n * 16] - ci[n] * bi[n * 16], zi = cr[n] * bi[n * 16] + ci[n] * br[n * 16];
      const f32x4* pr = (const f32x4*)(PWr + (dir * 64 + n) * PWP); const f32x4* pi = (const f32x4*)(PWi + (dir * 64 + n) * PWP);
#pragma unroll
      for (int k = 0; k < 8; ++k) tk[k] += pr[k] * zr - pi[k] * zi; }
#pragma unroll
    for (int k = 0; k < 32; ++k) TK[(dir * 32 + k) * 256 + pp * 16 + j] = tk[k >> 2][k & 3]; }
  __syncthreads();
  { bf16_t* WT = (bf16_t*)(p.ws + WS_WT) + (size_t)g * 512 * UA_K; const float* d_skip = p.in[I_DSKIP];
    for (int idx = tid; idx < 256 * (UA_K / 8); idx += 512) { const int r = idx / (UA_K / 8), k0 = (idx % (UA_K / 8)) * 8, i = 16 * half + r / 16, pp = r % 16; float v[8];
      if (k0 < 512) { const int s_ = k0 >> 4, j0 = k0 & 15;
#pragma unroll
        for (int e = 0; e < 8; ++e) v[e] = 0.f;
        if (s_ <= i) { const f32x4 a = *(const f32x4*)(TK + ((i - s_) * 16 + pp) * 16 + j0), b = *(const f32x4*)(TK + ((i - s_) * 16 + pp) * 16 + j0 + 4);
#pragma unroll
          for (int e = 0; e < 4; ++e) { v[e] += a[e]; v[4 + e] += b[e]; } }
        if (s_ >= i) { const f32x4 a = *(const f32x4*)(TK + 8192 + ((s_ - i) * 16 + pp) * 16 + j0), b = *(const f32x4*)(TK + 8192 + ((s_ - i) * 16 + pp) * 16 + j0 + 4);
#pragma unroll
          for (int e = 0; e < 4; ++e) { v[e] += a[e]; v[4 + e] += b[e]; } }
        if (s_ == i && pp >= j0 && pp < j0 + 8) { const float dsk = d_skip[g * 16 + pp];
#pragma unroll
          for (int e = 0; e < 8; ++e) if (j0 + e == pp) v[e] += dsk; } }
      else { const int q = k0 - 512, dir = q >> 7, im = (q >> 6) & 1, n0 = q & 63, pw = dir ? (CL - i) : (i + 1);
#pragma unroll
        for (int e = 0; e < 8; ++e) { const int n = n0 + e; const float cr = CCr[(dir * 16 + pp) * 64 + n], ci = CCi[(dir * 16 + pp) * 64 + n], pr = PWr[(dir * 64 + n) * PWP + pw], pi = PWi[(dir * 64 + n) * PWP + pw];
          v[e] = im ? -(cr * pi + ci * pr) : (cr * pr - ci * pi); } }
      u32x4 w; w.x = pk2(v[0], v[1]); w.y = pk2(v[2], v[3]); w.z = pk2(v[4], v[5]); w.w = pk2(v[6], v[7]);
      *(u32x4*)(WT + (size_t)(i * 16 + pp) * UA_K + k0) = w; } }
  { bf16_t* W1 = (bf16_t*)(p.ws + WS_W1) + (size_t)g * 256 * 512;
    for (int idx = tid; idx < 128 * 64; idx += 512) { const int r = 128 * half + idx / 64, k0 = (idx % 64) * 8, s_ = k0 >> 4, j0 = k0 & 15, dir = r >> 7, im = (r >> 6) & 1, n = r & 63, pw = dir ? s_ : (CL - 1 - s_);
      const float pr = PWr[(dir * 64 + n) * PWP + pw], pi = PWi[(dir * 64 + n) * PWP + pw]; float v[8];
#pragma unroll
      for (int e = 0; e < 8; ++e) { const float br = BBr[dir * 1024 + n * 16 + j0 + e], bi = BBi[dir * 1024 + n * 16 + j0 + e]; v[e] = im ? (pr * bi + pi * br) : (pr * br - pi * bi); }
      u32x4 w; w.x = pk2(v[0], v[1]); w.y = pk2(v[2], v[3]); w.z = pk2(v[4], v[5]); w.w = pk2(v[6], v[7]);
      *(u32x4*)(W1 + (size_t)r * 512 + k0) = w; } }
  if (half == 0 && tid < 128) { const int dir = tid >> 6, n = tid & 63; float* AL = (float*)(p.ws + WS_AL); AL[((g * 2 + dir) * 64 + n) * 2] = PWr[(dir * 64 + n) * PWP + CL]; AL[((g * 2 + dir) * 64 + n) * 2 + 1] = PWi[(dir * 64 + n) * PWP + CL]; }
  __syncthreads();
}

__device__ __forceinline__ void phase_pro(const Params& p, unsigned char* lds) {
  const int tid = threadIdx.x, lane = tid & 63, wave = tid >> 6, G = gridDim.x, blk = blockIdx.x;
  char* ws = p.ws;
  { float* red = (float*)lds; float* sil = (float*)(lds + 16384);
    const float* c = p.in[I_C]; const float* cc = p.in[I_CCTX]; const float* w_mod = p.in[I_WMOD]; const float* b_mod = p.in[I_BMOD]; float* mod = (float*)(ws + WS_MOD);
    if (blk < 192) { for (int i = tid; i < 5 * 1024; i += 512) { const int r = i >> 10, k = i & 1023; const float v = r < 4 ? c[r * 1024 + k] : cc[k]; sil[k * 5 + r] = v * sigmoidf_(v); } __syncthreads(); }
    for (int it = blk; it < 192; it += G) {
      const int col = it * 32 + (tid & 31), kg = tid >> 5; float a[5] = {0.f, 0.f, 0.f, 0.f, 0.f};
#pragma unroll 4
      for (int k = kg * 64; k < kg * 64 + 64; ++k) { const float w = w_mod[(size_t)k * 6144 + col];
#pragma unroll
        for (int r = 0; r < 5; ++r) a[r] += sil[k * 5 + r] * w; }
#pragma unroll
      for (int r = 0; r < 5; ++r) red[(kg * 5 + r) * 32 + (tid & 31)] = a[r];
      __syncthreads();
      if (tid < 160) { const int r = tid >> 5, q = tid & 31; float s = 0.f; for (int g = 0; g < 16; ++g) s += red[(g * 5 + r) * 32 + q]; mod[r * 6144 + it * 32 + q] = s + b_mod[it * 32 + q]; }
      __syncthreads();
    } }
  for (int task = G - 1 - blk; task < 64; task += G) ssm_tables(p, lds, task >> 1, task & 1);
  if (blk == 0 && tid == 0) { float mq = 0.f, mk = 0.f; for (int d = 0; d < QKD; ++d) { mq = fmaxf(mq, fabsf(p.in[I_QNG][d])); mk = fmaxf(mk, fabsf(p.in[I_KNG][d])); } *(float*)(ws + WS_LBOUND) = QSCALE * (float)QKD * mq * mk; }
  { float* tab = (float*)(ws + WS_ROPE);
    for (int idx = blk * 512 + tid; idx < SEQ * 16; idx += G * 512) { const int t = idx >> 4, i = idx & 15; const float freq = powf(10000.f, -(float)(i & 7) / 8.f);
      const float ang = (float)(i < 8 ? (t >> 6) : (t & 63)) * freq; tab[idx * 2] = cosf(ang); tab[idx * 2 + 1] = sinf(ang); } }
  { float* z = (float*)(ws + WS_RSQ); for (int i = blk * 512 + tid; i < 2 * 33792; i += G * 512) z[i] = 0.f; }
  { u32x4* z = (u32x4*)((bf16_t*)(ws + WS_WIN) + (size_t)1184 * 1024); for (int i = blk * 512 + tid; i < 96 * 1024 / 8; i += G * 512) z[i] = (u32x4){0u, 0u, 0u, 0u}; }
  if (G < 128 || blk < G - 64)
  { float* scr = (float*)(lds + 16384 + wave * 8704); const int nb_ = G < 128 ? G : G - 64; const int gw = blk * 8 + wave, NGW = nb_ * 8;
    constexpr int I1 = 16 * 101, I2 = 6 * 24, I3 = 4 * 32, I4 = 8 * 32, I5 = 8 * 64, I6 = 16 * 32, I7 = 16 * 176, I8 = 44 * 32;
    for (int it = gw; it < I1 + I2 + I3 + I4 + I5 + I6 + I7 + I8; it += NGW) {
      int r = it;
      if (r < I1) { const int kb = r / 101, nb = r % 101, n0 = nb * 32; tr_item(p.in[I_WIN], INW, kb * 64, n0, (bf16_t*)(ws + WS_WIN), 1024, n0 < 1184 ? n0 : n0 + 96, nullptr, scr, lane); continue; } r -= I1;
      if (r < I2) { const int kb = r / 24, nb = r % 24; const int n0 = nb * 32, hd = n0 / 96; tr_item(p.in[I_WUQ], 768, kb * 64, n0, (bf16_t*)(ws + WS_WUQ), 384, (hd >> 1) * 256 + (hd & 1) * 96 + n0 % 96, p.in[I_QAG], scr, lane); continue; } r -= I2;
      if (r < I3) { const int kb = r / 32, nb = r % 32; tr_item(p.in[I_WUKV], 1024, kb * 64, nb * 32, (bf16_t*)(ws + WS_WUKV), 256, nb * 32, p.in[I_KVAG], scr, lane); continue; } r -= I3;
      if (r < I4) { const int kb = r / 32, nb = r % 32; tr_item(p.in[I_WOA], 1024, kb * 64, nb * 32, (bf16_t*)(ws + WS_WO), 512, nb * 32, nullptr, scr, lane); continue; } r -= I4;
      if (r < I5) { const int kb = r / 64, nb = r % 64; tr_item(p.in[I_WGLU], 2048, kb * 64, nb * 32, (bf16_t*)(ws + WS_WGLU), 512, glu_row(nb * 32, 1024), nullptr, scr, lane); continue; } r -= I5;
      if (r < I6) { const int kb = r / 32, nb = r % 32; tr_item(p.in[I_WOUT], 1024, kb * 64, nb * 32, (bf16_t*)(ws + WS_WOUT), 1024, nb * 32, nullptr, scr, lane); continue; } r -= I6;
      if (r < I7) { const int kb = r / 176, nb = r % 176; tr_item(p.in[I_WUP], 5632, kb * 64, nb * 32, (bf16_t*)(ws + WS_WUP), 1024, glu_row(nb * 32, FH), nullptr, scr, lane); continue; } r -= I7;
      { const int kb = r / 32, nb = r % 32; tr_item(p.in[I_WDN], 1024, kb * 64, nb * 32, (bf16_t*)(ws + WS_WDN), FH, nb * 32, nullptr, scr, lane); }
    } }
}

__device__ __forceinline__ void phase_norm(const float* xin, const float* ctxin, const float* g, const float* mod, int shoff, int scoff, bf16_t* H, int nrows) {
  const int lane = threadIdx.x & 63, gw = blockIdx.x * 8 + (threadIdx.x >> 6), NGW = gridDim.x * 8;
  auto rowsrc = [&](int row, bool ok, const float*& src, int& mr) { if (!ok) { src = xin; mr = 0; } else if (row < NTOK) { src = xin + (size_t)row * 1024; mr = row / SEQ; } else { src = ctxin + (size_t)(row - NTOK) * 1024; mr = 4; } };
  f32x4 v0[4], v1[4]; int mr0 = 0, mr1 = 0;
  if (gw < nrows) { const float* s0; const float* s1; rowsrc(gw, true, s0, mr0); rowsrc(gw + NGW, gw + NGW < nrows, s1, mr1);
#pragma unroll
    for (int j = 0; j < 4; ++j) { v0[j] = ((const f32x4*)s0)[128 * (j >> 1) + 2 * lane + (j & 1)]; v1[j] = ((const f32x4*)s1)[128 * (j >> 1) + 2 * lane + (j & 1)]; } }
  for (int row0 = gw; row0 < nrows; row0 += 2 * NGW) {
    const int row1 = row0 + NGW; const bool has1 = row1 < nrows;
    const int nr0 = row0 + 2 * NGW, nr1 = nr0 + NGW; f32x4 n0[4], n1[4]; int nm0 = 0, nm1 = 0;
    if (nr0 < nrows) { const float* s0; const float* s1; rowsrc(nr0, true, s0, nm0); rowsrc(nr1, nr1 < nrows, s1, nm1);
#pragma unroll
      for (int j = 0; j < 4; ++j) { n0[j] = ((const f32x4*)s0)[128 * (j >> 1) + 2 * lane + (j & 1)]; n1[j] = ((const f32x4*)s1)[128 * (j >> 1) + 2 * lane + (j & 1)]; } }
    float s0 = 0.f, s1 = 0.f;
#pragma unroll
    for (int j = 0; j < 4; ++j) { s0 += (v0[j][0] * v0[j][0] + v0[j][1] * v0[j][1]) + (v0[j][2] * v0[j][2] + v0[j][3] * v0[j][3]); s1 += (v1[j][0] * v1[j][0] + v1[j][1] * v1[j][1]) + (v1[j][2] * v1[j][2] + v1[j][3] * v1[j][3]); }
    const float rs0 = rsqrtf(wave_sum(s0) * (1.f / 1024.f) + EPS), rs1 = rsqrtf(wave_sum(s1) * (1.f / 1024.f) + EPS);
    const float* m0 = mod + mr0 * 6144; const float* m1 = mod + mr1 * 6144; u32x4* o0 = (u32x4*)(H + (size_t)row0 * 1024) + lane; u32x4* o1 = (u32x4*)(H + (size_t)row1 * 1024) + lane;
#pragma unroll
    for (int jj = 0; jj < 2; ++jj) { const int c0 = 512 * jj + 8 * lane; const f32x4 ga = *(const f32x4*)(g + c0), gb = *(const f32x4*)(g + c0 + 4);
      { const f32x4 sca = *(const f32x4*)(m0 + scoff + c0), scb = *(const f32x4*)(m0 + scoff + c0 + 4), sha = *(const f32x4*)(m0 + shoff + c0), shb = *(const f32x4*)(m0 + shoff + c0 + 4);
        o0[64 * jj] = pack8(v0[2 * jj] * rs0 * ga * (sca + 1.f) + sha, v0[2 * jj + 1] * rs0 * gb * (scb + 1.f) + shb); }
      if (has1) { const f32x4 sca = *(const f32x4*)(m1 + scoff + c0), scb = *(const f32x4*)(m1 + scoff + c0 + 4), sha = *(const f32x4*)(m1 + shoff + c0), shb = *(const f32x4*)(m1 + shoff + c0 + 4);
        o1[64 * jj] = pack8(v1[2 * jj] * rs1 * ga * (sca + 1.f) + sha, v1[2 * jj + 1] * rs1 * gb * (scb + 1.f) + shb); } }
#pragma unroll
    for (int j = 0; j < 4; ++j) { v0[j] = n0[j]; v1[j] = n1[j]; }
    mr0 = nm0; mr1 = nm1;
  }
}

#define LAS __attribute__((address_space(3)))
#define XB_TMO      128
#define XB_XCNT(j)  (256  + 64 * (j))
#define XB_XSUB(j)  (1280 + 64 * (j))
#define XB_XGEN(j)  (2304 + 64 * (j))
#define XB_TOP      3328
#define XB_TOPGEN   3392
#define XCD_BAR_WORDS 3456
#define XB_SPIN_CAP (1u << 18)

__device__ __forceinline__ unsigned xb_ld(unsigned* p)              { return __hip_atomic_load(p, __ATOMIC_RELAXED, __HIP_MEMORY_SCOPE_AGENT); }
__device__ __forceinline__ unsigned xb_add(unsigned* p, unsigned v) { return __hip_atomic_fetch_add(p, v, __ATOMIC_RELAXED, __HIP_MEMORY_SCOPE_AGENT); }
__device__ __forceinline__ unsigned xb_xcc_id() { return (unsigned)__builtin_amdgcn_s_getreg((3 << 11) | 20) & 0xFu; }
#define XB_SPIN(cond, bar) do { unsigned _sp = 0; while (cond) { __builtin_amdgcn_s_sleep(1); \
    if ((++_sp & 255u) == 0u) { if (xb_ld(&(bar)[XB_TMO])) break; if (_sp > XB_SPIN_CAP) { atomicAdd(&(bar)[XB_TMO], 1u); break; } } } } while (0)

struct XcdBarrier {
    unsigned* bar; unsigned x;
    volatile LAS unsigned* st;
};

__device__ __forceinline__ XcdBarrier xcd_barrier_post(unsigned* bar, volatile LAS unsigned* st) {
    XcdBarrier b; b.bar = bar; b.x = xb_xcc_id(); b.st = st;
    if (threadIdx.x == 0) (void)xb_add(&bar[XB_XCNT(b.x)], 1u);
    return b;
}
__device__ __forceinline__ void xcd_barrier_complete(unsigned* bar, unsigned x, unsigned& nloc, unsigned& nx) {
    const unsigned G = gridDim.x * gridDim.y * gridDim.z;
    unsigned sum, cnt, mine, sp = 0u;
    for (;;) {
        sum = 0u; cnt = 0u; mine = 0u;
#pragma unroll
        for (unsigned j = 0; j < 16; ++j) { const unsigned c = xb_ld(&bar[XB_XCNT(j)]); sum += c; cnt += (c > 0u) ? 1u : 0u; mine = (j == x) ? c : mine; }
        if (sum == G) break;
        __builtin_amdgcn_s_sleep(1);
        if ((++sp & 255u) == 0u) { if (xb_ld(&bar[XB_TMO])) break; if (sp > XB_SPIN_CAP) { atomicAdd(&bar[XB_TMO], 1u); break; } }
    }
    nloc = mine > 0u ? mine : 1u; nx = cnt > 0u ? cnt : 1u;
}

__device__ __forceinline__ void xcd_barrier(const XcdBarrier& b) {
    asm volatile("s_waitcnt vmcnt(0)" ::: "memory");
    __syncthreads();
    if (threadIdx.x == 0) {
        unsigned* bar = b.bar;
        __builtin_amdgcn_s_waitcnt(0);
        unsigned nloc = b.st[0], nx = b.st[1];
        if (nloc == 0u) { xcd_barrier_complete(bar, b.x, nloc, nx); b.st[0] = nloc; b.st[1] = nx; }
        const unsigned old = xb_add(&bar[XB_XSUB(b.x)], 1u);
        const unsigned gen = old / nloc;
        if (old + 1u == (gen + 1u) * nloc) {
            __builtin_amdgcn_fence(__ATOMIC_RELEASE, "agent");
            asm volatile("s_waitcnt vmcnt(0)" ::: "memory");
            const unsigned og = xb_add(&bar[XB_TOP], 1u);
            const unsigned tg = og / nx;
            if (og + 1u == (tg + 1u) * nx) xb_add(&bar[XB_TOPGEN], 1u);
            else XB_SPIN(xb_ld(&bar[XB_TOPGEN]) == tg, bar);
            __builtin_amdgcn_fence(__ATOMIC_ACQUIRE, "agent");
            xb_add(&bar[XB_XGEN(b.x)], 1u);
            asm volatile("s_waitcnt vmcnt(0)" ::: "memory");
        } else {
            XB_SPIN(xb_ld(&bar[XB_XGEN(b.x)]) == gen, bar);
            __builtin_amdgcn_fence(__ATOMIC_ACQUIRE, "agent");
            asm volatile("s_waitcnt vmcnt(0)" ::: "memory");
        }
    }
    __syncthreads();
}

#ifndef PROBE_MASK
#define PROBE_MASK 0
#endif
#define NREP(x) (((PROBE_MASK >> (x)) & 1) ? 2 : 1)
#ifndef ONLY_PH
#define ONLY_PH -1
#endif
#define PHX(x) (ph_lo <= (x) && (x) <= ph_hi && (ONLY_PH < 0 || ONLY_PH == (x)))
#define PHSYNC(x) do { if (ph_lo <= (x) && (x) < ph_hi) { if (ph_hi >= 1000) grid.sync(); else xcd_barrier(xbar); } } while (0)
enum { PH_PRO = 0, PH_HN, PH_G1, PH_QKV, PH_SCAN, PH_SSMO, PH_GLU, PH_ATT, PH_WO, PH_WOUT, PH_HN2, PH_UP, PH_DOWN, PH_COUNT };
__global__ void __launch_bounds__(512, 2) mega(Params p) {
  extern __shared__ __attribute__((aligned(16))) unsigned char lds[];
  cg::grid_group grid = cg::this_grid();
  char* ws = p.ws; const int G = gridDim.x, blk = blockIdx.x, ph_lo = p.ph_lo, ph_hi = p.ph_hi;
  PG8_LAS unsigned char* ring = (PG8_LAS unsigned char*)lds;
  float* mod = (float*)(ws + WS_MOD);
  volatile LAS unsigned* bst = (volatile LAS unsigned*)((LAS unsigned char*)lds + 131072 + 12288);
  if (threadIdx.x < 2) bst[threadIdx.x] = 0u;
  __syncthreads();
  const XcdBarrier xbar = xcd_barrier_post((unsigned*)(ws + WS_BAR), bst);
  {
    if (PHX(PH_PRO)) for (int rep_ = 0; rep_ < NREP(PH_PRO); ++rep_) phase_pro(p, lds);
    PHSYNC(PH_PRO);
    if (PHX(PH_HN)) { phase_norm(p.in[I_X], p.in[I_CTX], p.in[I_N1G], mod, 0, 1024, (bf16_t*)(ws + WS_H), MALL); }
    PHSYNC(PH_HN);
    if (PHX(PH_G1)) for (int rep_ = 0; rep_ < NREP(PH_G1); ++rep_) {
      pg8::Gemm g{1024, 1024, 1024}; InOrder S; S.T.init(ws + WS_H, 1024, ws + WS_WIN, 1024, NTOK, WIN_N, G, blk); S.G = G; S.c = blk; S.A = ws + WS_H; S.B = ws + WS_WIN;
      EpiIn E{(bf16_t*)(ws + WS_CQ), (bf16_t*)(ws + WS_CKV), (bf16_t*)(ws + WS_KR), (bf16_t*)(ws + WS_UA), (bf16_t*)(ws + WS_GL), (float*)(ws + WS_RSQ), (float*)(ws + WS_RSK), (float*)(ws + WS_RSR)};
      pg8::gemm_phase<EpiIn, InOrder, true, true>(ring, g, S, E);
    }
    PHSYNC(PH_G1);
    if (PHX(PH_QKV)) for (int rep_ = 0; rep_ < NREP(PH_QKV); ++rep_) {
      const float* rope = (const float*)(ws + WS_ROPE); float* ex = (float*)(lds + 131072);
#ifndef NO_Q
      { int kq = QL; asm volatile("" : "+s"(kq));
        pg8::Gemm g{kq, QL, QL}; pg8::TileOrder S; S.init(ws + WS_CQ, QL, ws + WS_WUQ, QL, NTOK, 1024, G, blk);
        EpiQ E{(const float*)(ws + WS_RSQ), p.in[I_QNG], rope, (bf16_t*)(ws + WS_Q), ex};
#ifdef Q_TRIV
        EpiS E2{(float*)(ws + WS_S)}; pg8::gemm_phase<EpiS, pg8::TileOrder, true, true>(ring, g, S, E2); }
#else
        pg8::gemm_phase<EpiQ, pg8::TileOrder, true, true>(ring, g, S, E); }
#endif
#endif
#ifndef NO_KV
      { int kk = KVL; asm volatile("" : "+s"(kk));
        pg8::Gemm g{kk, KVL, KVL}; pg8::TileOrder S; S.init(ws + WS_CKV, KVL, ws + WS_WUKV, KVL, NTOK, 1024, G, blk);
        EpiKV E{(const float*)(ws + WS_RSK), (const float*)(ws + WS_RSR), (const bf16_t*)(ws + WS_KR), p.in[I_KNG], rope, (bf16_t*)(ws + WS_K), (bf16_t*)(ws + WS_V), ex};
        pg8::gemm_phase<EpiKV, pg8::TileOrder, true, true>(ring, g, S, E); }
#endif
#ifndef NO_S
      { pg8::Gemm g{512, UA_K, 512}; SOrder S{G, blk, ws + WS_UA, ws + WS_W1}; EpiS E{(float*)(ws + WS_S)};
        pg8::gemm_phase<EpiS, SOrder, true, true>(ring, g, S, E); }
#endif
      { int kk = KVL; asm volatile("" : "+s"(kk));
        pg8::Gemm g{kk, KVL, KVL}; CtxOrder S{G, blk, ws + WS_CKV, ws + WS_WUKV};
        EpiKV E{(const float*)(ws + WS_RSK), (const float*)(ws + WS_RSR), (const bf16_t*)(ws + WS_KR), p.in[I_KNG], rope, (bf16_t*)(ws + WS_K), (bf16_t*)(ws + WS_V), ex};
        pg8::gemm_phase<EpiKV, CtxOrder, true, true>(ring, g, S, E); }
    }
    PHSYNC(PH_QKV);
    if (PHX(PH_SCAN)) for (int rep_ = 0; rep_ < NREP(PH_SCAN); ++rep_) {
      float* seg = (float*)lds;
      for (int task = blk; task < NB * NG * 2; task += G) {
        const int n = threadIdx.x & 63, w = threadIdx.x >> 6, dir = task & 1, g = (task >> 1) & 31, b = task >> 6;
        const float* Sp = (const float*)(ws + WS_S) + (size_t)g * UA_ROWS * 256 + dir * 128 + n;
        bf16_t* X = (bf16_t*)(ws + WS_UA) + (size_t)g * UA_ROWS * UA_K + 512 + dir * 128 + n;
        const float* AL = (const float*)(ws + WS_AL); const float alr = AL[((g * 2 + dir) * 64 + n) * 2], ali = AL[((g * 2 + dir) * 64 + n) * 2 + 1];
        float sr[33], si[33];
#pragma unroll
        for (int i = 0; i < 33; ++i) { const int q = 33 * w + i; const int row = q < NCHC ? NB * NCHL + b * NCHC + (dir ? NCHC - 1 - q : q) : b * NCHL + (dir ? NCHL - 1 - (q - NCHC) : (q - NCHC));
          sr[i] = Sp[(size_t)row * 256]; si[i] = Sp[(size_t)row * 256 + 64]; }
        float xr = 0.f, xi = 0.f, pr = 1.f, pi = 0.f;
#pragma unroll
        for (int i = 0; i < 33; ++i) { const float t = alr * xr - ali * xi + sr[i]; xi = alr * xi + ali * xr + si[i]; xr = t; const float u = alr * pr - ali * pi; pi = alr * pi + ali * pr; pr = u; }
        seg[(w * 64 + n) * 2] = xr; seg[(w * 64 + n) * 2 + 1] = xi;
        __syncthreads();
        xr = 0.f; xi = 0.f;
        for (int v = 0; v < w; ++v) { const float br = seg[(v * 64 + n) * 2], bi = seg[(v * 64 + n) * 2 + 1]; const float t = pr * xr - pi * xi + br; xi = pr * xi + pi * xr + bi; xr = t; }
#pragma unroll
        for (int i = 0; i < 33; ++i) { const int q = 33 * w + i;
          if (q >= NCHC) { const int row = b * NCHL + (dir ? NCHL - 1 - (q - NCHC) : (q - NCHC)); X[(size_t)row * UA_K] = f2bf(xr); X[(size_t)row * UA_K + 64] = f2bf(xi); }
          const float t = alr * xr - ali * xi + sr[i]; xi = alr * xi + ali * xr + si[i]; xr = t; }
        __syncthreads();
      }
    }
    PHSYNC(PH_SCAN);
    if (PHX(PH_SSMO)) for (int rep_ = 0; rep_ < NREP(PH_SSMO); ++rep_) {
      pg8::Gemm g{UA_K, UA_K, UA_K}; YOrder S{G, blk, ws + WS_UA, ws + WS_WT}; EpiY E{(bf16_t*)(ws + WS_GY)};
      pg8::gemm_phase<EpiY, YOrder, true, true>(ring, g, S, E);
    }
    PHSYNC(PH_SSMO);
    if (PHX(PH_GLU)) for (int rep_ = 0; rep_ < NREP(PH_GLU); ++rep_) {
      pg8::Gemm g{512, 512, 512}; pg8::TileOrder S; S.init(ws + WS_GY, 512, ws + WS_WGLU, 512, NTOK, 2048, G, blk);
      EpiGlu E{(const bf16_t*)(ws + WS_GL), (bf16_t*)(ws + WS_MS)};
      pg8::gemm_phase<EpiGlu, pg8::TileOrder, true, true>(ring, g, S, E);
    }
    if (PHX(PH_ATT)) for (int rep_ = 0; rep_ < NREP(PH_ATT); ++rep_) {
      const bool fastsm = *(const float*)(ws + WS_LBOUND) <= 64.f;
      for (int un = blk; un < NB * NH * (SEQ / 256); un += G) {
        const int x = un & 7, rest = un >> 3, qb = rest & 31, bh = x * 4 + (rest >> 5), b = bh >> 3, h = bh & 7;
        if (fastsm) att::attn_unit<true>((const bf16_t*)(ws + WS_Q) + ((size_t)bh * SEQ + qb * 256) * QKD, (const bf16_t*)(ws + WS_K) + (size_t)bh * SKV * KP, (const bf16_t*)(ws + WS_V) + (size_t)bh * SKV * VD,
                       (bf16_t*)(ws + WS_O) + ((size_t)(b * SEQ + qb * 256)) * AW + h * VD, SKV, (char*)lds);
        else att::attn_unit<false>((const bf16_t*)(ws + WS_Q) + ((size_t)bh * SEQ + qb * 256) * QKD, (const bf16_t*)(ws + WS_K) + (size_t)bh * SKV * KP, (const bf16_t*)(ws + WS_V) + (size_t)bh * SKV * VD,
                       (bf16_t*)(ws + WS_O) + ((size_t)(b * SEQ + qb * 256)) * AW + h * VD, SKV, (char*)lds);
      }
    }
    PHSYNC(PH_ATT);
    if (PHX(PH_WO)) for (int rep_ = 0; rep_ < NREP(PH_WO); ++rep_) {
      pg8::Gemm g{512, 512, 512}; pg8::TileOrder S; S.init(ws + WS_O, 512, ws + WS_WO, 512, NTOK, 1024, G, blk);
      EpiWo E{(const bf16_t*)(ws + WS_GL), (const bf16_t*)(ws + WS_MS), (bf16_t*)(ws + WS_MM)};
      pg8::gemm_phase<EpiWo, pg8::TileOrder, true, true>(ring, g, S, E);
    }
    PHSYNC(PH_WO);
    if (PHX(PH_WOUT)) for (int rep_ = 0; rep_ < NREP(PH_WOUT); ++rep_) {
      pg8::Gemm g{1024, 1024, 1024}; pg8::TileOrder S; S.init(ws + WS_MM, 1024, ws + WS_WOUT, 1024, NTOK, 1024, G, blk);
      EpiRes E{p.in[I_X], mod, 2048, p.out};
      pg8::gemm_phase<EpiRes, pg8::TileOrder, true, true>(ring, g, S, E);
    }
    PHSYNC(PH_WOUT);
    if (PHX(PH_HN2)) { phase_norm(p.out, nullptr, p.in[I_N2G], mod, 3072, 4096, (bf16_t*)(ws + WS_H2), NTOK); }
    PHSYNC(PH_HN2);
    if (PHX(PH_UP)) for (int rep_ = 0; rep_ < NREP(PH_UP); ++rep_) {
      pg8::Gemm g{1024, 1024, 1024}; UpOrder S; S.T.init(ws + WS_H2, 1024, ws + WS_WUP, 1024, 132 * 256, 5632, G, blk); S.A = ws + WS_H2;
      EpiUp E{p.in[I_CONVW], p.in[I_CONVB], (bf16_t*)(ws + WS_ACT), (float*)(lds + 131072)};
      pg8::gemm_phase<EpiUp, UpOrder, true, true>(ring, g, S, E);
    }
    PHSYNC(PH_UP);
    if (PHX(PH_DOWN)) for (int rep_ = 0; rep_ < NREP(PH_DOWN); ++rep_) {
      pg8::Gemm g{FH, FH, FH}; pg8::TileOrder S; S.init(ws + WS_ACT, FH, ws + WS_WDN, FH, NTOK, 1024, G, blk);
      EpiRes E{p.out, mod, 5120, p.out};
      pg8::gemm_phase<EpiRes, pg8::TileOrder, true, true>(ring, g, S, E);
    }
  }
}

extern "C" void kernel_launch(void* const* d_in, const int* in_sizes, int n_in, void* d_out, int out_size, void* d_ws, size_t ws_size, hipStream_t stream) {
  static int grid = 0;
  if (grid == 0) {
    if (n_in != 35 || ws_size < WS_NEED) { fprintf(stderr, "kernel_launch: bad args n_in %d ws %zu\n", n_in, ws_size); grid = -1; return; }
    int dev = 0, cus = 0, per_cu = 0;
    hipGetDevice(&dev); hipDeviceGetAttribute(&cus, hipDeviceAttributeMultiprocessorCount, dev);
    if (hipFuncSetAttribute((const void*)mega, hipFuncAttributeMaxDynamicSharedMemorySize, LDS_BYTES) != hipSuccess) { fprintf(stderr, "kernel_launch: hipFuncSetAttribute failed\n"); grid = -1; return; }
    if (hipOccupancyMaxActiveBlocksPerMultiprocessor(&per_cu, (const void*)mega, 512, LDS_BYTES) != hipSuccess || per_cu < 1) { fprintf(stderr, "kernel_launch: occupancy query failed (%d)\n", per_cu); grid = -1; return; }
    grid = cus * per_cu;
    fprintf(stderr, "kernel_launch: cus %d per_cu %d grid %d\n", cus, per_cu, grid);
  }
  if (grid < 0) return;
  Params p{};
  for (int i = 0; i < 35; ++i) p.in[i] = (const float*)d_in[i];
  p.out = (float*)d_out; p.ws = (char*)d_ws;
  char* ws = (char*)d_ws; float* out = (float*)d_out;
  float* rope = (float*)(ws + WS_ROPE);
  bf16_t* H2 = (bf16_t*)(ws + WS_H2); float* Y = (float*)(ws + WS_Y);
  bf16_t* CQ = (bf16_t*)(ws + WS_CQ); bf16_t* CKV = (bf16_t*)(ws + WS_CKV); bf16_t* KR = (bf16_t*)(ws + WS_KR); bf16_t* GY = (bf16_t*)(ws + WS_GY);
  bf16_t* UA = (bf16_t*)(ws + WS_UA); bf16_t* O = (bf16_t*)(ws + WS_O); bf16_t* Q = (bf16_t*)(ws + WS_Q); bf16_t* ACT = (bf16_t*)(ws + WS_ACT);
  bf16_t* Kb = (bf16_t*)(ws + WS_K); bf16_t* Vb = (bf16_t*)(ws + WS_V);
  const float** in = p.in;
#define MEGA(lo, hi) do { p.ph_lo = (lo); p.ph_hi = (hi); if ((lo) == (hi)) hipLaunchKernelGGL(mega, dim3(grid), dim3(512), LDS_BYTES, stream, p); \
    else { void* args[] = {&p}; hipError_t e = hipLaunchCooperativeKernel((const void*)mega, dim3(grid), dim3(512), args, LDS_BYTES, stream); if (e != hipSuccess) fprintf(stderr, "cooperative launch failed: %s\n", hipGetErrorString(e)); } } while (0)
  if (hipMemsetAsync((char*)d_ws + WS_BAR, 0, 16384, stream) != hipSuccess) { fprintf(stderr, "kernel_launch: memset failed\n"); return; }
  MEGA(PH_PRO, PH_DOWN);
  (void)out;
}
```
